# Optimizing an MI355X kernel written in HIP

```python
import jax, jax.numpy as jnp
from jax import lax
import numpy as np

D_MODEL = 2048
BATCH = 4
SEQ = 2048
DEPTH = 4

GRID_W = 64
CTX_LEN = 256
N_MIXERS = 2
EXPAND = 2
D_BRANCH = EXPAND * D_MODEL
RET_HEADS = 8
RET_QK_DIM = D_MODEL // RET_HEADS
RET_V_DIM = D_BRANCH // RET_HEADS
RET_CHUNK = 128
NA_HEADS = 32
NA_HEAD_DIM = D_BRANCH // NA_HEADS
NA_WIN_H = 8
NA_WIN_W = 16
NA_QBLOCK_W = 16
ROPE_BASE = 10000.0
EPS = 1e-6

kernel_name = 'hybrid_retention_natten_prefix_dit'


def rmsnorm(x, g):
    xf = x.astype(jnp.float32)
    y = xf * lax.rsqrt(jnp.mean(xf * xf, axis=-1, keepdims=True) + EPS)
    return (y * g.astype(jnp.float32)).astype(x.dtype)


def head_norm(x):
    xf = x.astype(jnp.float32)
    return (xf * lax.rsqrt(jnp.mean(xf * xf, axis=-1, keepdims=True) + EPS)).astype(x.dtype)


def to_heads(a, n_heads):
    b, t, _ = a.shape
    return a.reshape(b, t, n_heads, -1).transpose(0, 2, 1, 3)


def from_heads(a):
    b, h, t, d = a.shape
    return a.transpose(0, 2, 1, 3).reshape(b, t, h * d)


def rope_1d(x, pos):
    half = x.shape[-1] // 2
    freqs = ROPE_BASE ** (-jnp.arange(half, dtype=jnp.float32) / half)
    ang = pos.astype(jnp.float32)[:, None] * freqs[None, :]
    cos = jnp.cos(ang).astype(x.dtype)
    sin = jnp.sin(ang).astype(x.dtype)
    x1, x2 = x[..., :half], x[..., half:]
    return jnp.concatenate([x1 * cos - x2 * sin, x1 * sin + x2 * cos], axis=-1)


def rope_2d(x, row, col):
    a = x.shape[-1] // 2
    return jnp.concatenate([rope_1d(x[..., :a], row), rope_1d(x[..., a:], col)], axis=-1)


def retention_scan(q, k, v, log_g, s0):
    b, h, t, dk = q.shape
    dv = v.shape[-1]
    n = t // RET_CHUNK
    pos = jnp.arange(RET_CHUNK, dtype=jnp.float32)
    diff = pos[:, None] - pos[None, :]
    lg = log_g[:, None, None]
    intra = jnp.where(diff >= 0, jnp.exp(lg * jnp.maximum(diff, 0.0)), 0.0).astype(q.dtype)
    q_dec = jnp.exp(log_g[:, None] * (pos + 1.0))[..., None].astype(q.dtype)
    k_dec = jnp.exp(log_g[:, None] * (RET_CHUNK - 1.0 - pos))[..., None].astype(q.dtype)
    c_dec = jnp.exp(log_g * RET_CHUNK)[:, None, None].astype(q.dtype)

    def chunks(a):
        return a.reshape(b, h, n, RET_CHUNK, a.shape[-1]).transpose(2, 0, 1, 3, 4)

    def step(s, inp):
        qc, kc, vc = inp
        scores = jnp.einsum('bhid,bhjd->bhij', qc, kc) * intra
        o = jnp.einsum('bhij,bhjv->bhiv', scores, vc) + jnp.einsum('bhid,bhdv->bhiv', qc * q_dec, s)
        s_new = s * c_dec + jnp.einsum('bhjd,bhjv->bhdv', kc * k_dec, vc)
        return s_new.astype(s.dtype), o

    s_fin, o = lax.scan(step, s0, (chunks(q), chunks(k), chunks(v)))
    return o.transpose(1, 2, 0, 3, 4).reshape(b, h, t, dv), s_fin


def retention_branch(h, hc, w_in, raw_fwd, raw_bwd, w_out, row_pos, col_pos, with_ctx_out):
    b = h.shape[0]
    cut = [D_MODEL, 2 * D_MODEL, 2 * D_MODEL + D_BRANCH]
    q, k, v, g = jnp.split(h @ w_in, cut, axis=-1)
    qc, kc, vc, gc = jnp.split(hc @ w_in, cut, axis=-1)
    q, k, v = to_heads(q, RET_HEADS), to_heads(k, RET_HEADS), to_heads(v, RET_HEADS)
    qc, kc, vc = to_heads(qc, RET_HEADS), to_heads(kc, RET_HEADS), to_heads(vc, RET_HEADS)
    q = rope_2d(q, row_pos, col_pos)
    k = rope_2d(k, row_pos, col_pos) * (RET_QK_DIM ** -0.5)
    kc = kc * (RET_QK_DIM ** -0.5)
    log_fwd = -jax.nn.softplus(raw_fwd.astype(jnp.float32))
    log_bwd = -jax.nn.softplus(raw_bwd.astype(jnp.float32))
    flip = lambda a: a[:, :, ::-1]
    zero = jnp.zeros((b, RET_HEADS, RET_QK_DIM, RET_V_DIM), h.dtype)
    oc_f, s_f = retention_scan(qc, kc, vc, log_fwd, zero)
    oc_b, s_b = retention_scan(flip(qc), flip(kc), flip(vc), log_bwd, zero)
    o_f, _ = retention_scan(q, k, v, log_fwd, s_f)
    o_b, _ = retention_scan(flip(q), flip(k), flip(v), log_bwd, s_b)
    o = head_norm(o_f + flip(o_b))
    y = (jax.nn.silu(g) * from_heads(o)) @ w_out
    if with_ctx_out:
        oc = head_norm(oc_f + flip(oc_b))
        yc = (jax.nn.silu(gc) * from_heads(oc)) @ w_out
        return y, yc
    return y, None


def na_branch(h, hc, w_in, rpb, w_out, with_ctx_out):
    b, t, _ = h.shape
    rows = t // GRID_W
    wh = min(NA_WIN_H, rows)
    scale = NA_HEAD_DIM ** -0.5
    q, k, v, g = jnp.split(h @ w_in, 4, axis=-1)
    qc, kc, vc, gc = jnp.split(hc @ w_in, 4, axis=-1)
    q, k, v = to_heads(q, NA_HEADS) * scale, to_heads(k, NA_HEADS), to_heads(v, NA_HEADS)
    qc, kc, vc = to_heads(qc, NA_HEADS) * scale, to_heads(kc, NA_HEADS), to_heads(vc, NA_HEADS)

    nqb = GRID_W // NA_QBLOCK_W
    kbw = NA_QBLOCK_W + NA_WIN_W
    qcol = np.arange(GRID_W).reshape(nqb, NA_QBLOCK_W)
    cb_start = np.clip(qcol[:, 0] - NA_WIN_W // 2, 0, GRID_W - kbw)
    kcol = cb_start[:, None] + np.arange(kbw)
    win_start = np.clip(qcol - NA_WIN_W // 2, 0, GRID_W - NA_WIN_W)
    col_valid = (kcol[:, None, :] >= win_start[..., None]) & (kcol[:, None, :] < win_start[..., None] + NA_WIN_W)
    col_idx = np.clip(kcol[:, None, :] - qcol[..., None] + NA_WIN_W - 1, 0, 2 * NA_WIN_W - 2)
    mask = jnp.asarray(np.broadcast_to(col_valid[:, :, None, :], (nqb, NA_QBLOCK_W, wh, kbw)).reshape(nqb, NA_QBLOCK_W, wh * kbw))

    q_grid = q.reshape(b, NA_HEADS, rows, GRID_W, NA_HEAD_DIM)
    k_grid = k.reshape(b, NA_HEADS, rows, GRID_W, NA_HEAD_DIM)
    v_grid = v.reshape(b, NA_HEADS, rows, GRID_W, NA_HEAD_DIM)

    def gather_block(a_grid, rs):
        a_rows = lax.dynamic_slice_in_dim(a_grid, rs, wh, axis=2)
        a_blk = a_rows[:, :, :, kcol]
        return a_blk.transpose(0, 1, 3, 2, 4, 5).reshape(b, NA_HEADS, nqb, wh * kbw, NA_HEAD_DIM)

    def row_fn(r):
        rs = jnp.clip(r - wh // 2, 0, rows - wh)
        k_blk = gather_block(k_grid, rs)
        v_blk = gather_block(v_grid, rs)
        q_r = lax.dynamic_index_in_dim(q_grid, r, axis=2, keepdims=False).reshape(b, NA_HEADS, nqb, NA_QBLOCK_W, NA_HEAD_DIM)
        row_idx = rs + jnp.arange(wh) - r + NA_WIN_H - 1
        bias = rpb[:, row_idx][:, :, col_idx]
        bias = bias.transpose(0, 2, 3, 1, 4).reshape(NA_HEADS, nqb, NA_QBLOCK_W, wh * kbw)
        s_loc = jnp.einsum('bhnqd,bhnkd->bhnqk', q_r, k_blk) + bias
        s_loc = jnp.where(mask, s_loc.astype(jnp.float32), -jnp.inf)
        s_ctx = jnp.einsum('bhnqd,bhcd->bhnqc', q_r, kc).astype(jnp.float32)
        p = jax.nn.softmax(jnp.concatenate([s_loc, s_ctx], axis=-1), axis=-1).astype(v.dtype)
        p_loc, p_ctx = p[..., :wh * kbw], p[..., wh * kbw:]
        o = jnp.einsum('bhnqk,bhnkd->bhnqd', p_loc, v_blk) + jnp.einsum('bhnqc,bhcd->bhnqd', p_ctx, vc)
        return o.reshape(b, NA_HEADS, GRID_W, NA_HEAD_DIM)

    o = lax.map(row_fn, jnp.arange(rows))
    o = o.transpose(1, 0, 3, 2, 4).reshape(b, t, NA_HEADS * NA_HEAD_DIM)
    y = (jax.nn.silu(g) * o) @ w_out
    if with_ctx_out:
        sc = jnp.einsum('bhqd,bhkd->bhqk', qc, kc).astype(jnp.float32)
        pc = jax.nn.softmax(sc, axis=-1).astype(vc.dtype)
        oc = from_heads(jnp.einsum('bhqk,bhkd->bhqd', pc, vc))
        yc = (jax.nn.silu(gc) * oc) @ w_out
        return y, yc
    return y, None


def setup_inputs(seed: int = 0) -> dict:
    key = jax.random.key(seed)
    ks = jax.random.split(key, 16)
    f32 = jnp.float32
    n_ret = (DEPTH + N_MIXERS - 1) // N_MIXERS
    n_na = DEPTH // N_MIXERS
    nrm = lambda k, s: jax.random.normal(k, s, f32)
    x = nrm(ks[0], (BATCH, SEQ, D_MODEL))
    c = nrm(ks[1], (BATCH, D_MODEL))
    ctx = nrm(ks[2], (BATCH, CTX_LEN, D_MODEL))
    c_ctx = nrm(ks[3], (D_MODEL,))
    mod_w = nrm(ks[4], (DEPTH, D_MODEL, 3 * D_MODEL)) * (0.5 * D_MODEL ** -0.5)
    mod_b = 0.01 * nrm(ks[5], (DEPTH, 3 * D_MODEL))
    norm_g = 1.0 + 0.02 * nrm(ks[6], (DEPTH, D_MODEL))
    ret_w_in = nrm(ks[7], (n_ret, D_MODEL, 2 * D_MODEL + 2 * D_BRANCH)) * (D_MODEL ** -0.5)
    neg_log_gamma = -jnp.log1p(-(2.0 ** (-5.0 - jnp.arange(RET_HEADS, dtype=f32))))
    raw = jnp.log(jnp.expm1(neg_log_gamma))
    ret_decay_fwd = raw[None] + 0.1 * nrm(ks[8], (n_ret, RET_HEADS))
    ret_decay_bwd = raw[None] + 0.1 * nrm(ks[9], (n_ret, RET_HEADS))
    ret_w_out = nrm(ks[10], (n_ret, D_BRANCH, D_MODEL)) * (D_BRANCH ** -0.5)
    na_w_in = nrm(ks[11], (n_na, D_MODEL, 4 * D_BRANCH)) * (D_MODEL ** -0.5)
    na_rpb = 0.02 * nrm(ks[12], (n_na, NA_HEADS, 2 * NA_WIN_H - 1, 2 * NA_WIN_W - 1))
    na_w_out = nrm(ks[13], (n_na, D_BRANCH, D_MODEL)) * (D_BRANCH ** -0.5)
    final_g = 1.0 + 0.02 * nrm(ks[14], (D_MODEL,))
    return {'x': x, 'c': c, 'ctx': ctx, 'c_ctx': c_ctx, 'mod_w': mod_w, 'mod_b': mod_b, 'norm_g': norm_g,
            'ret_w_in': ret_w_in, 'ret_decay_fwd': ret_decay_fwd, 'ret_decay_bwd': ret_decay_bwd, 'ret_w_out': ret_w_out,
            'na_w_in': na_w_in, 'na_rpb': na_rpb, 'na_w_out': na_w_out, 'final_g': final_g}


def reference(x, c, ctx, c_ctx, mod_w, mod_b, norm_g, ret_w_in, ret_decay_fwd, ret_decay_bwd, ret_w_out,
              na_w_in, na_rpb, na_w_out, final_g):
    n_tok = x.shape[1]
    t = jnp.arange(n_tok)
    row_pos = t // GRID_W
    col_pos = t % GRID_W
    cond_lat = jax.nn.silu(c)
    cond_ctx = jax.nn.silu(c_ctx)
    for l in range(DEPTH):
        last = l == DEPTH - 1
        sh, sc, gt = jnp.split(cond_lat @ mod_w[l] + mod_b[l], 3, axis=-1)
        shc, scc, gtc = jnp.split(cond_ctx @ mod_w[l] + mod_b[l], 3, axis=-1)
        h = rmsnorm(x, norm_g[l]) * (1.0 + sc[:, None]) + sh[:, None]
        hc = rmsnorm(ctx, norm_g[l]) * (1.0 + scc) + shc
        j = l // N_MIXERS
        if l % N_MIXERS == 0:
            y, yc = retention_branch(h, hc, ret_w_in[j], ret_decay_fwd[j], ret_decay_bwd[j], ret_w_out[j],
                                     row_pos, col_pos, not last)
        else:
            y, yc = na_branch(h, hc, na_w_in[j], na_rpb[j], na_w_out[j], not last)
        x = x + gt[:, None] * y
        if not last:
            ctx = ctx + gtc * yc
    return rmsnorm(x, final_g)
```

```cpp
#include <hip/hip_runtime.h>
#include <hip/hip_cooperative_groups.h>
#include <cstdio>
namespace cg = cooperative_groups;

#define LAS __attribute__((address_space(3)))
typedef unsigned short bf16_t;
typedef short bf16x8 __attribute__((ext_vector_type(8)));
typedef short s16x4 __attribute__((ext_vector_type(4)));
typedef float f32x4 __attribute__((ext_vector_type(4)));
typedef float f32x2 __attribute__((ext_vector_type(2)));
typedef unsigned u32x4 __attribute__((ext_vector_type(4)));
typedef unsigned u32x2 __attribute__((ext_vector_type(2)));

constexpr int DM = 2048, NB = 4, SEQ = 2048, CTXL = 256, EB = 4096;
constexpr int ML = NB * SEQ, MC = NB * CTXL, MT = ML + MC;
constexpr int NP_RET = 12288, NP_NA = 16384;
constexpr float EPS = 1e-6f;

constexpr size_t MiB = 1u << 20;
constexpr size_t WS_WRI0 = 0, WS_WRI1 = 48 * MiB, WS_WNI0 = 96 * MiB, WS_WNI1 = 160 * MiB;
constexpr size_t WS_WRO0 = 224 * MiB, WS_WRO1 = 240 * MiB, WS_WNO0 = 256 * MiB, WS_WNO1 = 272 * MiB;
constexpr size_t WS_MODV = 288 * MiB, WS_ROPE = 289 * MiB, WS_XS = 290 * MiB, WS_H = 362 * MiB;
constexpr size_t WS_PROJ = 398 * MiB, WS_GATED = 686 * MiB, WS_OFB = 758 * MiB, WS_PART = 902 * MiB, WS_BAR = 966 * MiB, WS_END = 967 * MiB;

constexpr int LDS_BYTES = 147456;

struct Params {
    const float *x, *c, *ctx, *c_ctx, *mod_w, *mod_b, *norm_g, *ret_w_in, *ret_df, *ret_db, *ret_w_out, *na_w_in, *na_rpb, *na_w_out, *final_g;
    float* out; unsigned char* ws;
};

__device__ __forceinline__ unsigned cvt_pk_bf16(float lo, float hi) { unsigned r; asm volatile("v_cvt_pk_bf16_f32 %0, %1, %2" : "=v"(r) : "v"(lo), "v"(hi)); return r; }
__device__ __forceinline__ float bf_lo(unsigned u) { return __uint_as_float(u << 16); }
__device__ __forceinline__ float bf_hi(unsigned u) { return __uint_as_float(u & 0xffff0000u); }
__device__ __forceinline__ float wave_sum(float v) {
#define WS_DPP(ctrl) v += __builtin_bit_cast(float, __builtin_amdgcn_update_dpp(0, __builtin_bit_cast(int, v), (ctrl), 0xf, 0xf, false))
    WS_DPP(0x128); WS_DPP(0x124); WS_DPP(0x122); WS_DPP(0x121);
#undef WS_DPP
    const int vi = __builtin_bit_cast(int, v);
    const float r0 = __builtin_bit_cast(float, __builtin_amdgcn_readlane(vi, 0)), r1 = __builtin_bit_cast(float, __builtin_amdgcn_readlane(vi, 16));
    const float r2 = __builtin_bit_cast(float, __builtin_amdgcn_readlane(vi, 32)), r3 = __builtin_bit_cast(float, __builtin_amdgcn_readlane(vi, 48));
    return (r0 + r1) + (r2 + r3);
}
__device__ __forceinline__ int opaque_tid() { int t = threadIdx.x; asm volatile("" : "+v"(t)); return t; }
template <class T> __device__ __forceinline__ T* opq(T* q) { __attribute__((address_space(1))) T* g = (__attribute__((address_space(1))) T*)q; asm volatile("" : "+s"(g)); return (T*)g; }
__device__ __forceinline__ float silu_f(float v) { return v / (1.0f + __expf(-v)); }
__device__ __forceinline__ s16x4 tr_read(LAS unsigned char* p) {
    typedef short v4i16_t __attribute__((ext_vector_type(4)));
    return __builtin_bit_cast(s16x4, __builtin_amdgcn_ds_read_tr16_b64_v4i16((LAS v4i16_t*)p));
}
__device__ __forceinline__ bf16x8 cat8(s16x4 lo, s16x4 hi) { const u32x2 a = __builtin_bit_cast(u32x2, lo), b = __builtin_bit_cast(u32x2, hi); u32x4 r; r.x = a.x; r.y = a.y; r.z = b.x; r.w = b.y; return __builtin_bit_cast(bf16x8, r); }
__device__ __forceinline__ bf16x8 pack8(f32x4 a, f32x4 b) {
    u32x4 w; w.x = cvt_pk_bf16(a[0], a[1]); w.y = cvt_pk_bf16(a[2], a[3]); w.z = cvt_pk_bf16(b[0], b[1]); w.w = cvt_pk_bf16(b[2], b[3]);
    return __builtin_bit_cast(bf16x8, w);
}

namespace pg8 {
constexpr int BM = 256, BK = 64, HALF = 128, HTB = HALF * BK * 2, STAGE_BYTES = 8 * HTB, NXCD = 8, WGM = 8;
__host__ __device__ __forceinline__ int lds_byte(int r, int c) { const int st = (r >> 4) * 2 + (c >> 5), rr = r & 15, cc = c & 31, ob = rr * 64 + cc * 2; return st * 1024 + (ob ^ (((ob >> 9) & 1) << 5)); }
__host__ __device__ __forceinline__ void stage_rc(int b, int& R, int& C) { const int st = b / 1024, sb = b % 1024, swz = sb ^ (((sb >> 9) & 1) << 5); R = (st >> 1) * 16 + swz / 64; C = (st & 1) * 32 + (swz % 64) / 2; }
__host__ __device__ __forceinline__ int perm32(int rho) { const int n = rho >> 4, i = rho & 15; return 8 * (i >> 2) + 4 * n + (i & 3); }

struct Unit { int pm, pn, ks; };
struct Gemm { const bf16_t* A; const bf16_t* Bt; int M, N, K, ld; };

struct StaticOrder {
    int nM, nN, nwg, G, c;
    __device__ void init(int M, int N, int G_, int c_) { nM = M / BM; nN = N / BM; nwg = nM * nN; G = G_; c = c_; }
    __device__ bool next(int i, Unit& u) const {
        const long L = (long)i * G + c; if (L >= nwg) return false;
        int wgid = (int)L; { const int q = nwg / NXCD, r = nwg % NXCD, xcd = wgid % NXCD, off = wgid / NXCD; wgid = (xcd < r ? xcd * (q + 1) : r * (q + 1) + (xcd - r) * q) + off; }
        const int nig = WGM * nN, gid = wgid / nig, fm = gid * WGM, gsz = (nM - fm) < WGM ? (nM - fm) : WGM;
        u.pm = fm + ((wgid % nig) % gsz); u.pn = (wgid % nig) / gsz; u.ks = 0; return true;
    }
    __device__ __forceinline__ void a_ready(const Unit&) const {}
    __device__ __forceinline__ void done(const Unit&) const {}
};

struct SplitOrder {
    int nM, nN, nS, nwg, G, c;
    __device__ void init(int M, int N, int nS_, int G_, int c_) { nM = M / BM; nN = N / BM; nS = nS_; nwg = nM * nN * nS; G = G_; c = c_; }
    __device__ bool next(int i, Unit& u) const {
        const long L = (long)i * G + c; if (L >= nwg) return false;
        const int l = (int)L; u.ks = l % nS; const int t = l / nS; u.pm = t % nM; u.pn = t / nM; return true;
    }
    __device__ __forceinline__ void a_ready(const Unit&) const {}
    __device__ __forceinline__ void done(const Unit&) const {}
};
struct EpiPartial {
    static constexpr bool PERM = false;
    float* P; int rows, ldc;
    __device__ __forceinline__ void operator()(const f32x4 (&acc)[2][2][4][2], const Unit& u, int wr, int wc, int fr, int fq) const {
        const int row0 = u.pm * BM + wr * 64 + fr, col0 = u.pn * BM + wc * 32 + 4 * fq;
        float* base = P + (size_t)u.ks * rows * ldc;
#pragma unroll
        for (int ai = 0; ai < 2; ++ai)
#pragma unroll
            for (int m = 0; m < 4; ++m) { float* rowp = base + (size_t)(row0 + ai * HALF + m * 16) * ldc + col0;
#pragma unroll
                for (int bj = 0; bj < 2; ++bj)
#pragma unroll
                    for (int n = 0; n < 2; ++n) *(f32x4*)(rowp + bj * HALF + n * 16) = acc[ai][bj][m][n]; }
    }
};
struct EpiBf16 {
    static constexpr bool PERM = true;
    bf16_t* O; int ldc;
    __device__ __forceinline__ void operator()(const f32x4 (&acc)[2][2][4][2], const Unit& u, int wr, int wc, int fr, int fq) const {
        const int row0 = u.pm * BM + wr * 64 + fr; const int col0 = u.pn * BM + wc * 32 + 8 * fq;
#pragma unroll
        for (int ai = 0; ai < 2; ++ai)
#pragma unroll
            for (int m = 0; m < 4; ++m) { bf16_t* rowp = O + (size_t)(row0 + ai * HALF + m * 16) * ldc + col0;
#pragma unroll
                for (int bj = 0; bj < 2; ++bj) { const f32x4 v0 = acc[ai][bj][m][0], v1 = acc[ai][bj][m][1];
                    u32x4 w; w.x = cvt_pk_bf16(v0[0], v0[1]); w.y = cvt_pk_bf16(v0[2], v0[3]); w.z = cvt_pk_bf16(v1[0], v1[1]); w.w = cvt_pk_bf16(v1[2], v1[3]);
                    *(u32x4*)(rowp + bj * HALF) = w; } }
    }
};
struct EpiResid {
    static constexpr bool PERM = false;
    const float* xsrc; float* xout; const float* gt_base;
    __device__ __forceinline__ void operator()(const f32x4 (&acc)[2][2][4][2], const Unit& u, int wr, int wc, int fr, int fq) const {
        const int row0 = u.pm * BM + wr * 64 + fr, col0 = u.pn * BM + wc * 32 + 4 * fq;
        const int mrow = (u.pm * BM < ML) ? ((u.pm * BM) >> 11) : 4;
        const float* gt = gt_base + mrow * 6144;
        f32x4 gv[2][2];
#pragma unroll
        for (int bj = 0; bj < 2; ++bj)
#pragma unroll
            for (int n = 0; n < 2; ++n) gv[bj][n] = *(const f32x4*)(gt + col0 + bj * HALF + n * 16);
#pragma unroll
        for (int ai = 0; ai < 2; ++ai) {
            f32x4 xv[4][2][2];
#pragma unroll
            for (int m = 0; m < 4; ++m) { const float* sp = xsrc + (size_t)(row0 + ai * HALF + m * 16) * DM;
#pragma unroll
                for (int bj = 0; bj < 2; ++bj)
#pragma unroll
                    for (int n = 0; n < 2; ++n) xv[m][bj][n] = *(const f32x4*)(sp + col0 + bj * HALF + n * 16); }
#pragma unroll
            for (int m = 0; m < 4; ++m) { float* dp = xout + (size_t)(row0 + ai * HALF + m * 16) * DM;
#pragma unroll
                for (int bj = 0; bj < 2; ++bj)
#pragma unroll
                    for (int n = 0; n < 2; ++n) *(f32x4*)(dp + col0 + bj * HALF + n * 16) = xv[m][bj][n] + gv[bj][n] * acc[ai][bj][m][n]; }
        }
    }
};

template <class Epi, class Sched, bool ALIGN_EPI = true, bool SP2 = true>
__device__ __forceinline__ void gemm_phase(LAS unsigned char* lds, const Gemm g, const Sched& S, const Epi& E) {
    const int tid = opaque_tid(), wid = __builtin_amdgcn_readfirstlane(tid >> 6), lane = tid & 63, wr = wid >> 2, wc = wid & 3, fr = lane & 15, fq = lane >> 4;
    const int K = g.ld, nt = g.K / BK;
    unsigned voffA[2], voffB[2];
#pragma unroll
    for (int i = 0; i < 2; ++i) { int R, C; stage_rc(tid * 16 + i * 8192, R, C); const int Rb = Epi::PERM ? ((R & ~31) + perm32(R & 31)) : R;
        voffA[i] = (unsigned)(R * K + C) * 2u; voffB[i] = (unsigned)(Rb * K + C) * 2u; }
    const size_t kstep = (size_t)(BK * 2);
    const size_t hstep = (size_t)HALF * K * 2;
    const size_t tstep = 2 * hstep;
    const unsigned ldsw = (unsigned)wid * 1024u;
    const int aoff = lds_byte(wr * 64 + fr, fq * 8), boff = lds_byte(wc * 32 + fr, fq * 8);
#define PG8_SA(b, h) (((b) * 2 + (h)) * HTB)
#define PG8_SB(b, h) ((4 + (b) * 2 + (h)) * HTB)
#define PG8_STAGE(bufoff, gbase, voff) do { _Pragma("unroll") for (int _i = 0; _i < 2; ++_i) \
        __builtin_amdgcn_global_load_lds((const unsigned*)((const char*)(gbase) + (voff)[_i]), (LAS unsigned*)(lds + (bufoff) + ldsw + _i * 8192), 16, 0, 0); } while (0)
#define PG8_LDA(dst, b, h) do { _Pragma("unroll") for (int m = 0; m < 4; ++m) _Pragma("unroll") for (int k = 0; k < 2; ++k) dst[m][k] = *(const LAS bf16x8*)(lds + PG8_SA(b, h) + aoff + m * 2048 + k * 1024); } while (0)
#define PG8_LDB(dst, b, h) do { _Pragma("unroll") for (int n = 0; n < 2; ++n) _Pragma("unroll") for (int k = 0; k < 2; ++k) dst[n][k] = *(const LAS bf16x8*)(lds + PG8_SB(b, h) + boff + n * 2048 + k * 1024); } while (0)
#define PG8_MMA(ai, bj, At, Bt) do { __builtin_amdgcn_s_setprio(1); _Pragma("unroll") for (int m = 0; m < 4; ++m) _Pragma("unroll") for (int n = 0; n < 2; ++n) _Pragma("unroll") for (int k = 0; k < 2; ++k) \
        acc[ai][bj][m][n] = __builtin_amdgcn_mfma_f32_16x16x32_bf16(Bt[n][k], At[m][k], acc[ai][bj][m][n], 0, 0, 0); __builtin_amdgcn_s_setprio(0); } while (0)
#define PG8_WAIT_V(n) asm volatile("s_waitcnt vmcnt(" #n ")" ::: "memory")
#define PG8_WAIT_L(n) asm volatile("s_waitcnt lgkmcnt(" #n ")" ::: "memory")
#define PG8_BAR __builtin_amdgcn_s_barrier()
#define PG8_SCHED __builtin_amdgcn_sched_barrier(0)
    Unit cur, nxt; int ui = 0;
    if (!S.next(0, cur)) return;
    f32x4 acc[2][2][4][2];
#pragma unroll
    for (int a = 0; a < 2; ++a)
#pragma unroll
        for (int b = 0; b < 2; ++b)
#pragma unroll
            for (int m = 0; m < 4; ++m)
#pragma unroll
                for (int n = 0; n < 2; ++n) acc[a][b][m][n] = (f32x4){0.f, 0.f, 0.f, 0.f};
    bf16x8 At[4][2], B0[2][2], B1[2][2];
    const size_t ksb = (size_t)g.K * 2;
    const char* cA = (const char*)g.A + (size_t)cur.pm * tstep + cur.ks * ksb; const char* cB = (const char*)g.Bt + (size_t)cur.pn * tstep + cur.ks * ksb;
    S.a_ready(cur);
    if constexpr (SP2) {
        PG8_STAGE(PG8_SB(0, 0), cB, voffB); PG8_STAGE(PG8_SB(0, 1), cB + hstep, voffB); PG8_STAGE(PG8_SA(0, 0), cA, voffA); PG8_STAGE(PG8_SA(0, 1), cA + hstep, voffA);
        if (wr == 1) PG8_BAR;
        PG8_WAIT_V(2); PG8_BAR;
        PG8_STAGE(PG8_SB(1, 0), cB + kstep, voffB); PG8_STAGE(PG8_SA(1, 0), cA + kstep, voffA); PG8_STAGE(PG8_SB(1, 1), cB + hstep + kstep, voffB);
        PG8_WAIT_V(6); PG8_BAR;
    } else {
        PG8_STAGE(PG8_SB(0, 0), cB, voffB); PG8_STAGE(PG8_SA(0, 0), cA, voffA); PG8_STAGE(PG8_SB(0, 1), cB + hstep, voffB); PG8_STAGE(PG8_SA(0, 1), cA + hstep, voffA);
        if (wr == 1) PG8_BAR;
        PG8_WAIT_V(4); PG8_BAR;
        PG8_STAGE(PG8_SB(1, 0), cB + kstep, voffB); PG8_STAGE(PG8_SA(1, 0), cA + kstep, voffA); PG8_STAGE(PG8_SB(1, 1), cB + hstep + kstep, voffB);
        PG8_WAIT_V(6); PG8_BAR;
    }
    for (;;) {
        const bool has_next = S.next(ui + 1, nxt);
        const char* nA = has_next ? (const char*)g.A + (size_t)nxt.pm * tstep + nxt.ks * ksb : cA; const char* nB = has_next ? (const char*)g.Bt + (size_t)nxt.pn * tstep + nxt.ks * ksb : cB;
        for (int t = 0; t < nt; t += 2) {
            const bool last = (t == nt - 2);
            const char* a1 = cA + (size_t)(t + 1) * kstep;
            const char* a2 = last ? nA : cA + (size_t)(t + 2) * kstep; const char* b2 = last ? nB : cB + (size_t)(t + 2) * kstep;
            const char* a3 = a2 + kstep; const char* b3 = b2 + kstep;
            if (last && has_next) S.a_ready(nxt);
            if constexpr (SP2) {
            PG8_LDB(B0, 0, 0); PG8_LDB(B1, 0, 1); PG8_SCHED; PG8_LDA(At, 0, 0); PG8_STAGE(PG8_SA(1, 1), a1 + hstep, voffA);
            PG8_WAIT_V(8); PG8_WAIT_L(0); PG8_BAR; PG8_MMA(0, 0, At, B0); PG8_MMA(0, 1, At, B1); PG8_BAR; PG8_SCHED;
            PG8_LDA(At, 0, 1); PG8_STAGE(PG8_SB(0, 0), b2, voffB); PG8_STAGE(PG8_SB(0, 1), b2 + hstep, voffB); PG8_STAGE(PG8_SA(0, 0), a2, voffA);
            PG8_WAIT_V(8); PG8_WAIT_L(0); PG8_BAR; PG8_MMA(1, 0, At, B0); PG8_MMA(1, 1, At, B1); PG8_BAR; PG8_SCHED;
            PG8_LDB(B0, 1, 0); PG8_LDB(B1, 1, 1); PG8_SCHED; PG8_LDA(At, 1, 0); PG8_STAGE(PG8_SA(0, 1), a2 + hstep, voffA);
            PG8_WAIT_V(8); PG8_WAIT_L(0); PG8_BAR; PG8_MMA(0, 0, At, B0); PG8_MMA(0, 1, At, B1); PG8_BAR; PG8_SCHED;
            PG8_LDA(At, 1, 1); PG8_STAGE(PG8_SB(1, 0), b3, voffB); PG8_STAGE(PG8_SB(1, 1), b3 + hstep, voffB); PG8_STAGE(PG8_SA(1, 0), a3, voffA);
            PG8_WAIT_V(8); PG8_WAIT_L(0); PG8_BAR; PG8_MMA(1, 0, At, B0); PG8_MMA(1, 1, At, B1); PG8_BAR; PG8_SCHED;
            } else {
            PG8_LDB(B0, 0, 0); PG8_SCHED; PG8_LDA(At, 0, 0); PG8_STAGE(PG8_SA(1, 1), a1 + hstep, voffA);
            PG8_WAIT_L(8); PG8_BAR; PG8_WAIT_L(0); PG8_MMA(0, 0, At, B0); PG8_BAR; PG8_SCHED;
            PG8_LDB(B1, 0, 1); PG8_STAGE(PG8_SB(0, 0), b2, voffB);
            PG8_BAR; PG8_WAIT_L(0); PG8_MMA(0, 1, At, B1); PG8_BAR;
            PG8_LDA(At, 0, 1); PG8_STAGE(PG8_SA(0, 0), a2, voffA);
            PG8_BAR; PG8_WAIT_L(0); PG8_MMA(1, 0, At, B0); PG8_BAR; PG8_SCHED;
            PG8_STAGE(PG8_SB(0, 1), b2 + hstep, voffB);
            PG8_WAIT_V(6); PG8_BAR; PG8_MMA(1, 1, At, B1); PG8_BAR;
            PG8_LDB(B0, 1, 0); PG8_SCHED; PG8_LDA(At, 1, 0); PG8_STAGE(PG8_SA(0, 1), a2 + hstep, voffA);
            PG8_WAIT_L(8); PG8_BAR; PG8_WAIT_L(0); PG8_MMA(0, 0, At, B0); PG8_BAR; PG8_SCHED;
            PG8_LDB(B1, 1, 1); PG8_STAGE(PG8_SB(1, 0), b3, voffB);
            PG8_BAR; PG8_WAIT_L(0); PG8_MMA(0, 1, At, B1); PG8_BAR;
            PG8_LDA(At, 1, 1); PG8_STAGE(PG8_SA(1, 0), a3, voffA);
            PG8_BAR; PG8_WAIT_L(0); PG8_MMA(1, 0, At, B0); PG8_BAR; PG8_SCHED;
            PG8_STAGE(PG8_SB(1, 1), b3 + hstep, voffB);
            PG8_WAIT_V(6); PG8_BAR; PG8_MMA(1, 1, At, B1); PG8_BAR;
            }
        }
        if constexpr (ALIGN_EPI) { if (wr == 0) PG8_BAR; }
        E(acc, cur, wr, wc, fr, fq); S.done(cur);
        if (!has_next) break;
#pragma unroll
        for (int a = 0; a < 2; ++a)
#pragma unroll
            for (int b = 0; b < 2; ++b)
#pragma unroll
                for (int m = 0; m < 4; ++m)
#pragma unroll
                    for (int n = 0; n < 2; ++n) acc[a][b][m][n] = (f32x4){0.f, 0.f, 0.f, 0.f};
        cur = nxt; cA = nA; cB = nB; ++ui;
        if constexpr (ALIGN_EPI) { if (wr == 1) PG8_BAR; }
    }
    PG8_WAIT_V(0);
    if constexpr (!ALIGN_EPI) { if (wr == 0) PG8_BAR; }
    PG8_BAR;
#undef PG8_SA
#undef PG8_SB
#undef PG8_STAGE
#undef PG8_LDA
#undef PG8_LDB
#undef PG8_MMA
#undef PG8_WAIT_V
#undef PG8_WAIT_L
#undef PG8_BAR
#undef PG8_SCHED
}
}

__device__ __forceinline__ void transpose_item(const float* W, int K, int N, bf16_t* WT, LAS float* scr, int item, int lane) {
    const int nblk = N >> 6, kb = item / nblk, nb = item - kb * nblk, k0 = kb * 64, n0 = nb * 64;
    const float* src = W + (size_t)k0 * N + n0 + lane;
#pragma unroll 16
    for (int i = 0; i < 64; ++i) scr[i * 65 + lane] = __builtin_nontemporal_load(src + (size_t)i * N);
    asm volatile("s_waitcnt lgkmcnt(0)" ::: "memory");
    const int c = lane & 7;
#pragma unroll
    for (int j = 0; j < 8; ++j) { const int n = (lane >> 3) + 8 * j; const LAS float* s = scr + (8 * c) * 65 + n;
        u32x4 o; o.x = cvt_pk_bf16(s[0], s[65]); o.y = cvt_pk_bf16(s[2 * 65], s[3 * 65]); o.z = cvt_pk_bf16(s[4 * 65], s[5 * 65]); o.w = cvt_pk_bf16(s[6 * 65], s[7 * 65]);
        *(u32x4*)(WT + (size_t)(n0 + n) * K + k0 + 8 * c) = o; }
    asm volatile("s_waitcnt lgkmcnt(0)" ::: "memory");
}

__device__ __forceinline__ void prologue(const Params& p, LAS unsigned char* lds) {
    unsigned char* ws_ = opq(p.ws);
    const int tid = opaque_tid(), lane = tid & 63, wave = tid >> 6;
    LAS float* cs = (LAS float*)lds;
    LAS float* red = (LAS float*)(lds + 40960);
    for (int i = tid; i < 5 * DM; i += 512) { const float v = (i < 4 * DM) ? opq(p.c)[i] : opq(p.c_ctx)[i - 4 * DM]; cs[i] = v / (1.0f + expf(-v)); }
    __syncthreads();
    float* modv = (float*)(ws_ + WS_MODV);
    for (int item = blockIdx.x; item < 384; item += gridDim.x) {
        const int l = item / 96, cgp = item - l * 96;
        const float* W = opq(p.mod_w) + (size_t)l * DM * 6144 + cgp * 64 + lane;
        float a0 = 0.f, a1 = 0.f, a2 = 0.f, a3 = 0.f, a4 = 0.f;
        const int k0 = wave * 256;
#pragma unroll 8
        for (int k = k0; k < k0 + 256; ++k) { const float w = __builtin_nontemporal_load(W + (size_t)k * 6144); a0 += cs[k] * w; a1 += cs[DM + k] * w; a2 += cs[2 * DM + k] * w; a3 += cs[3 * DM + k] * w; a4 += cs[4 * DM + k] * w; }
        red[(wave * 5 + 0) * 64 + lane] = a0; red[(wave * 5 + 1) * 64 + lane] = a1; red[(wave * 5 + 2) * 64 + lane] = a2; red[(wave * 5 + 3) * 64 + lane] = a3; red[(wave * 5 + 4) * 64 + lane] = a4;
        __syncthreads();
        if (tid < 320) { const int r = tid >> 6; float s = 0.f;
#pragma unroll
            for (int w = 0; w < 8; ++w) s += red[(w * 5 + r) * 64 + lane];
            modv[(size_t)(l * 5 + r) * 6144 + cgp * 64 + lane] = s + opq(p.mod_b)[l * 6144 + cgp * 64 + lane]; }
        __syncthreads();
    }
    {
        const int gt = blockIdx.x * 512 + tid;
        if (gt < 4096) { const int pos = gt >> 6, f = gt & 63; const float freq = exp2f(-(float)f * (13.287712379549449f / 64.0f)); const float ang = (float)pos * freq;
            float sn, cn; sincosf(ang, &sn, &cn); ((f32x2*)(ws_ + WS_ROPE))[gt] = (f32x2){cn, sn}; }
    }
    __syncthreads();
    LAS float* scr = (LAS float*)(lds + wave * 16640);
    const int gw = blockIdx.x * 8 + wave, NGW = gridDim.x * 8;
    constexpr int I_RI = 32 * 192, I_NI = 32 * 256, I_O = 64 * 32;
    constexpr int NITEMS = 2 * I_RI + 2 * I_NI + 4 * I_O;
    for (int it = gw; it < NITEMS; it += NGW) {
        int r = it;
        if (r < I_RI) { transpose_item(opq(p.ret_w_in), DM, NP_RET, (bf16_t*)(ws_ + WS_WRI0), scr, r, lane); continue; } r -= I_RI;
        if (r < I_O) { transpose_item(opq(p.ret_w_out), EB, DM, (bf16_t*)(ws_ + WS_WRO0), scr, r, lane); continue; } r -= I_O;
        if (r < I_NI) { transpose_item(opq(p.na_w_in), DM, NP_NA, (bf16_t*)(ws_ + WS_WNI0), scr, r, lane); continue; } r -= I_NI;
        if (r < I_O) { transpose_item(opq(p.na_w_out), EB, DM, (bf16_t*)(ws_ + WS_WNO0), scr, r, lane); continue; } r -= I_O;
        if (r < I_RI) { transpose_item(opq(p.ret_w_in) + (size_t)DM * NP_RET, DM, NP_RET, (bf16_t*)(ws_ + WS_WRI1), scr, r, lane); continue; } r -= I_RI;
        if (r < I_O) { transpose_item(opq(p.ret_w_out) + (size_t)EB * DM, EB, DM, (bf16_t*)(ws_ + WS_WRO1), scr, r, lane); continue; } r -= I_O;
        if (r < I_NI) { transpose_item(opq(p.na_w_in) + (size_t)DM * NP_NA, DM, NP_NA, (bf16_t*)(ws_ + WS_WNI1), scr, r, lane); continue; } r -= I_NI;
        transpose_item(opq(p.na_w_out) + (size_t)EB * DM, EB, DM, (bf16_t*)(ws_ + WS_WNO1), scr, r, lane);
    }
    __syncthreads();
}

__device__ __forceinline__ void norm_emit(const f32x4 (&v)[8], const f32x4 (&gs)[8], const f32x4 (&sh)[8], bf16_t* hrow, int lane) {
    float ss = 0.f;
#pragma unroll
    for (int j = 0; j < 8; ++j) ss += (v[j][0] * v[j][0] + v[j][1] * v[j][1]) + (v[j][2] * v[j][2] + v[j][3] * v[j][3]);
    ss = wave_sum(ss);
    const float rstd = 1.0f / sqrtf(ss * (1.0f / DM) + EPS);
    u32x2* o = (u32x2*)hrow;
#pragma unroll
    for (int j = 0; j < 8; ++j) { const f32x4 hv = v[j] * rstd * gs[j] + sh[j];
        u32x2 w; w.x = cvt_pk_bf16(hv[0], hv[1]); w.y = cvt_pk_bf16(hv[2], hv[3]); o[lane + 64 * j] = w; }
}
__device__ __forceinline__ void norm_phase(const Params& p, int l) {
    unsigned char* ws_ = opq(p.ws);
    const int tid = opaque_tid(), lane = tid & 63, wave = tid >> 6;
    const int gw = blockIdx.x * 8 + wave, NGW = gridDim.x * 8;
    float* XS = (float*)(ws_ + WS_XS);
    const float* modv = (const float*)(ws_ + WS_MODV);
    const float* PART = (const float*)(ws_ + WS_PART);
    bf16_t* H = (bf16_t*)(ws_ + WS_H);
    const f32x4* g4 = (const f32x4*)(opq(p.norm_g) + l * DM);
    f32x4 gg[8];
#pragma unroll
    for (int j = 0; j < 8; ++j) gg[j] = g4[lane + 64 * j];
    for (int m = ML + gw; m < MT; m += NGW) {
        const float* src = (l <= 1) ? opq(p.ctx) + (size_t)(m - ML) * DM : XS + (size_t)m * DM;
        const f32x4* sh4 = (const f32x4*)(modv + (size_t)(l * 5 + 4) * 6144);
        f32x4 v[8], gs[8], sh[8];
#pragma unroll
        for (int j = 0; j < 8; ++j) { v[j] = ((const f32x4*)src)[lane + 64 * j]; gs[j] = gg[j] * (sh4[DM / 4 + lane + 64 * j] + 1.0f); sh[j] = sh4[lane + 64 * j]; }
        if (l != 0) {
            const f32x4* gt4 = (const f32x4*)(modv + (size_t)((l - 1) * 5 + 4) * 6144 + 4096);
            const f32x4* pp = (const f32x4*)(PART + (size_t)(m - ML) * DM);
#pragma unroll
            for (int j = 0; j < 8; ++j) { f32x4 a = (f32x4){0.f, 0.f, 0.f, 0.f};
#pragma unroll
                for (int sp = 0; sp < 8; ++sp) a += pp[(size_t)sp * (MC * DM / 4) + lane + 64 * j];
                v[j] += gt4[lane + 64 * j] * a; }
#pragma unroll
            for (int j = 0; j < 8; ++j) ((f32x4*)(XS + (size_t)m * DM))[lane + 64 * j] = v[j];
        }
        norm_emit(v, gs, sh, H + (size_t)m * DM, lane);
    }
    const float* lsrc = (l == 0) ? opq(p.x) : (const float*)XS;
    for (int m0 = gw * 2; m0 < ML; m0 += NGW * 2) {
        const f32x4* sh4 = (const f32x4*)(modv + (size_t)(l * 5 + (m0 >> 11)) * 6144);
        f32x4 va[8], vb[8], gs[8], sh[8];
#pragma unroll
        for (int j = 0; j < 8; ++j) { va[j] = ((const f32x4*)(lsrc + (size_t)m0 * DM))[lane + 64 * j]; vb[j] = ((const f32x4*)(lsrc + (size_t)(m0 + 1) * DM))[lane + 64 * j];
            gs[j] = gg[j] * (sh4[DM / 4 + lane + 64 * j] + 1.0f); sh[j] = sh4[lane + 64 * j]; }
        norm_emit(va, gs, sh, H + (size_t)m0 * DM, lane);
        norm_emit(vb, gs, sh, H + (size_t)(m0 + 1) * DM, lane);
    }
}
__device__ __forceinline__ void final_norm(const Params& p) {
    unsigned char* ws_ = opq(p.ws);
    const int tid = opaque_tid(), lane = tid & 63, wave = tid >> 6;
    const int gw = blockIdx.x * 8 + wave, NGW = gridDim.x * 8;
    const float* XS = (const float*)(ws_ + WS_XS);
    const f32x4* g4 = (const f32x4*)opq(p.final_g);
    float* outp = opq(p.out);
    f32x4 gg[8];
#pragma unroll
    for (int j = 0; j < 8; ++j) gg[j] = g4[lane + 64 * j];
    for (int m0 = gw * 2; m0 < ML; m0 += NGW * 2) {
        f32x4 v[2][8];
#pragma unroll
        for (int q = 0; q < 2; ++q)
#pragma unroll
            for (int j = 0; j < 8; ++j) v[q][j] = ((const f32x4*)(XS + (size_t)(m0 + q) * DM))[lane + 64 * j];
#pragma unroll
        for (int q = 0; q < 2; ++q) { float ss = 0.f;
#pragma unroll
            for (int j = 0; j < 8; ++j) ss += (v[q][j][0] * v[q][j][0] + v[q][j][1] * v[q][j][1]) + (v[q][j][2] * v[q][j][2] + v[q][j][3] * v[q][j][3]);
            ss = wave_sum(ss);
            const float rstd = 1.0f / sqrtf(ss * (1.0f / DM) + EPS);
            f32x4* o = (f32x4*)(outp + (size_t)(m0 + q) * DM);
#pragma unroll
            for (int j = 0; j < 8; ++j) o[lane + 64 * j] = v[q][j] * rstd * gg[j];
        }
    }
}

constexpr int RQ_STRIDE = 528, RK_STRIDE = 544, RV_STRIDE = 288, RP_STRIDE = 144;
constexpr int R_QS = 0, R_KS = 33792, R_VS = 68608, R_PS = 87040;
__device__ __forceinline__ void ret_phaseA(const Params& p, int j, LAS unsigned char* lds) {
    unsigned char* ws_ = opq(p.ws);
    const int tid = opaque_tid(), lane = tid & 63, w = __builtin_amdgcn_readfirstlane(tid >> 6), g = lane >> 4, li = lane & 15;
    const int tq = li >> 2, tp = li & 3;
    const bf16_t* PROJ = (const bf16_t*)(ws_ + WS_PROJ);
    bf16_t* OFB = (bf16_t*)(ws_ + WS_OFB);
    const f32x2* rope = (const f32x2*)(ws_ + WS_ROPE);
    LAS unsigned char* Qs = lds + R_QS; LAS unsigned char* Ks = lds + R_KS; LAS unsigned char* Vs = lds + R_VS; LAS unsigned char* Ps = lds + R_PS;
    for (int u = blockIdx.x; u < 256; u += gridDim.x) {
        const int slice = (u >> 3) & 3, grp = (u & 7) | ((u >> 5) << 3), dir = grp & 1, h = (grp >> 1) & 7, b = grp >> 4;
        const float raw = (dir ? opq(p.ret_db) : opq(p.ret_df))[j * 8 + h];
        const float lg = -log1pf(expf(raw));
        const float cdec = expf(lg * 64.0f);
        f32x4 S[16];
#pragma unroll
        for (int i = 0; i < 16; ++i) S[i] = (f32x4){0.f, 0.f, 0.f, 0.f};
        u32x4 pq[2][2], pk[2][2], pv[2];
#define RET_ROWBASE(s, rb, cc, isctx) do { isctx = (s) < 4; const int ci_ = isctx ? (s) : (s) - 4; const int nch_ = isctx ? 4 : 32; cc = dir ? nch_ - 1 - ci_ : ci_; \
        rb = isctx ? ML + b * CTXL + cc * 64 : b * SEQ + cc * 64; } while (0)
#define RET_LOAD(s) do { int rb_, cc_; bool ic_; RET_ROWBASE(s, rb_, cc_, ic_); _Pragma("unroll") for (int t = 0; t < 2; ++t) { const int tk = tid + 512 * t; const int row = tk >> 4, sub = tk & 15; \
        const int d0 = (sub >> 3) * 128 + (sub & 7) * 8; const bf16_t* sp = PROJ + (size_t)(rb_ + row) * NP_RET + h * 256 + d0; \
        pq[t][0] = *(const u32x4*)sp; pq[t][1] = *(const u32x4*)(sp + 64); pk[t][0] = *(const u32x4*)(sp + 2048); pk[t][1] = *(const u32x4*)(sp + 2048 + 64); \
        pv[t] = *(const u32x4*)(PROJ + (size_t)(rb_ + row) * NP_RET + 4096 + h * 512 + slice * 128 + sub * 8); } } while (0)
        RET_LOAD(0);
        for (int s = 0; s < 36; ++s) {
            int rowbase, cc; bool isctx; RET_ROWBASE(s, rowbase, cc, isctx);
#pragma unroll
            for (int t = 0; t < 2; ++t) {
                const int tk = tid + 512 * t; const int row = tk >> 4, sub = tk & 15; const int half = sub >> 3, gq = sub & 7; const int d0 = half * 128 + gq * 8;
                const float e_i = dir ? (float)(64 - row) : (float)(row + 1);
                const float fqs = expf(lg * e_i), fks = expf(-lg * e_i) * 0.0625f;
                float q1[8], q2[8], k1[8], k2[8];
#pragma unroll
                for (int e = 0; e < 4; ++e) { q1[2 * e] = bf_lo(pq[t][0][e]); q1[2 * e + 1] = bf_hi(pq[t][0][e]); q2[2 * e] = bf_lo(pq[t][1][e]); q2[2 * e + 1] = bf_hi(pq[t][1][e]);
                    k1[2 * e] = bf_lo(pk[t][0][e]); k1[2 * e + 1] = bf_hi(pk[t][0][e]); k2[2 * e] = bf_lo(pk[t][1][e]); k2[2 * e + 1] = bf_hi(pk[t][1][e]); }
                if (!isctx) {
                    const int pos = half ? row : cc;
                    const f32x4* rp = (const f32x4*)(rope + pos * 64 + gq * 8);
#pragma unroll
                    for (int e = 0; e < 4; ++e) { const f32x4 cs2 = rp[e];
                        { const float c0 = cs2[0], s0 = cs2[1]; const float a = q1[2 * e], bb = q2[2 * e]; q1[2 * e] = a * c0 - bb * s0; q2[2 * e] = a * s0 + bb * c0;
                          const float ka = k1[2 * e], kb = k2[2 * e]; k1[2 * e] = ka * c0 - kb * s0; k2[2 * e] = ka * s0 + kb * c0; }
                        { const float c0 = cs2[2], s0 = cs2[3]; const float a = q1[2 * e + 1], bb = q2[2 * e + 1]; q1[2 * e + 1] = a * c0 - bb * s0; q2[2 * e + 1] = a * s0 + bb * c0;
                          const float ka = k1[2 * e + 1], kb = k2[2 * e + 1]; k1[2 * e + 1] = ka * c0 - kb * s0; k2[2 * e + 1] = ka * s0 + kb * c0; } }
                }
                u32x4 o;
                o.x = cvt_pk_bf16(q1[0] * fqs, q1[1] * fqs); o.y = cvt_pk_bf16(q1[2] * fqs, q1[3] * fqs); o.z = cvt_pk_bf16(q1[4] * fqs, q1[5] * fqs); o.w = cvt_pk_bf16(q1[6] * fqs, q1[7] * fqs);
                *(LAS u32x4*)(Qs + row * RQ_STRIDE + d0 * 2) = o;
                o.x = cvt_pk_bf16(q2[0] * fqs, q2[1] * fqs); o.y = cvt_pk_bf16(q2[2] * fqs, q2[3] * fqs); o.z = cvt_pk_bf16(q2[4] * fqs, q2[5] * fqs); o.w = cvt_pk_bf16(q2[6] * fqs, q2[7] * fqs);
                *(LAS u32x4*)(Qs + row * RQ_STRIDE + (d0 + 64) * 2) = o;
                o.x = cvt_pk_bf16(k1[0] * fks, k1[1] * fks); o.y = cvt_pk_bf16(k1[2] * fks, k1[3] * fks); o.z = cvt_pk_bf16(k1[4] * fks, k1[5] * fks); o.w = cvt_pk_bf16(k1[6] * fks, k1[7] * fks);
                *(LAS u32x4*)(Ks + row * RK_STRIDE + d0 * 2) = o;
                o.x = cvt_pk_bf16(k2[0] * fks, k2[1] * fks); o.y = cvt_pk_bf16(k2[2] * fks, k2[3] * fks); o.z = cvt_pk_bf16(k2[4] * fks, k2[5] * fks); o.w = cvt_pk_bf16(k2[6] * fks, k2[7] * fks);
                *(LAS u32x4*)(Ks + row * RK_STRIDE + (d0 + 64) * 2) = o;
                *(LAS u32x4*)(Vs + row * RV_STRIDE + sub * 16) = pv[t];
            }
            __syncthreads();
            if (s + 1 < 36) RET_LOAD(s + 1);
            {
                const int ib = w >> 1;
#pragma unroll
                for (int t = 0; t < 2; ++t) {
                    const int jb = 2 * (w & 1) + t;
                    f32x4 acc = (f32x4){0.f, 0.f, 0.f, 0.f};
                    const bool nz = dir ? (jb >= ib) : (jb <= ib);
                    if (nz) {
                        const LAS unsigned char* kp_ = Ks + (jb * 16 + li) * RK_STRIDE + (8 * g) * 2; const LAS unsigned char* qp_ = Qs + (ib * 16 + li) * RQ_STRIDE + (8 * g) * 2;
                        bf16x8 na_ = *(const LAS bf16x8*)kp_, nb_ = *(const LAS bf16x8*)qp_, na2_ = *(const LAS bf16x8*)(kp_ + 64), nb2_ = *(const LAS bf16x8*)(qp_ + 64);
#pragma unroll
                        for (int kk = 0; kk < 8; ++kk) {
                            const bf16x8 a = na_, bq = nb_; na_ = na2_; nb_ = nb2_;
                            if (kk + 2 < 8) { na2_ = *(const LAS bf16x8*)(kp_ + (kk + 2) * 64); nb2_ = *(const LAS bf16x8*)(qp_ + (kk + 2) * 64); }
                            acc = __builtin_amdgcn_mfma_f32_16x16x32_bf16(a, bq, acc, 0, 0, 0);
                            __builtin_amdgcn_sched_barrier(0);
                        }
                        const int i = ib * 16 + li;
#pragma unroll
                        for (int r = 0; r < 4; ++r) { const int jj = jb * 16 + 4 * g + r; const bool keep = dir ? (jj >= i) : (jj <= i); acc[r] = keep ? acc[r] : 0.f; }
                    }
                    u32x2 wv; wv.x = cvt_pk_bf16(acc[0], acc[1]); wv.y = cvt_pk_bf16(acc[2], acc[3]);
                    *(LAS u32x2*)(Ps + (ib * 16 + li) * RP_STRIDE + (jb * 16 + 4 * g) * 2) = wv;
                }
            }
            f32x4 oacc[4];
#pragma unroll
            for (int ib = 0; ib < 4; ++ib) oacc[ib] = (f32x4){0.f, 0.f, 0.f, 0.f};
            {
                const LAS unsigned char* qa0 = Qs + li * RQ_STRIDE + (4 * g) * 2;
#define RET_QF(idx) cat8(*(const LAS s16x4*)(qa0 + ((idx) & 3) * 16 * RQ_STRIDE + ((idx) >> 2) * 64), *(const LAS s16x4*)(qa0 + ((idx) & 3) * 16 * RQ_STRIDE + ((idx) >> 2) * 64 + 32))
                bf16x8 qn0 = RET_QF(0), qn1 = RET_QF(1), qn2 = RET_QF(2);
#pragma unroll
                for (int T = 0; T < 8; ++T) {
                    const bf16x8 bfrag = pack8(S[2 * T], S[2 * T + 1]);
#pragma unroll
                    for (int ib = 0; ib < 4; ++ib) {
                        const int idx = T * 4 + ib; const bf16x8 a = qn0; qn0 = qn1; qn1 = qn2;
                        if (idx + 3 < 32) qn2 = RET_QF(idx + 3);
                        oacc[ib] = __builtin_amdgcn_mfma_f32_16x16x32_bf16(a, bfrag, oacc[ib], 0, 0, 0);
                        __builtin_amdgcn_sched_barrier(0);
                    }
                }
#undef RET_QF
            }
            bf16x8 vfrag[2];
#pragma unroll
            for (int ks = 0; ks < 2; ++ks) {
                LAS unsigned char* va = Vs + (32 * ks + 4 * g + tq) * RV_STRIDE + (w * 16 + 4 * tp) * 2;
                vfrag[ks] = cat8(tr_read(va), tr_read(va + 16 * RV_STRIDE));
            }
            {
                LAS unsigned char* ka0 = Ks + (4 * g + tq) * RK_STRIDE + (4 * tp) * 2;
#define RET_KF(idx) cat8(tr_read(ka0 + ((idx) & 1) * 32 * RK_STRIDE + ((idx) >> 1) * 32), tr_read(ka0 + ((idx) & 1) * 32 * RK_STRIDE + ((idx) >> 1) * 32 + 16 * RK_STRIDE))
                bf16x8 kn0 = RET_KF(0), kn1 = RET_KF(1), kn2 = RET_KF(2);
#pragma unroll
                for (int dkb = 0; dkb < 16; ++dkb) {
#pragma unroll
                    for (int ks = 0; ks < 2; ++ks) {
                        const int idx = dkb * 2 + ks; const bf16x8 a = kn0; kn0 = kn1; kn1 = kn2;
                        if (idx + 3 < 32) kn2 = RET_KF(idx + 3);
                        S[dkb] = __builtin_amdgcn_mfma_f32_16x16x32_bf16(a, vfrag[ks], S[dkb], 0, 0, 0);
                        __builtin_amdgcn_sched_barrier(0);
                    }
                    S[dkb] = S[dkb] * cdec;
                }
#undef RET_KF
            }
            __syncthreads();
#pragma unroll
            for (int ib = 0; ib < 4; ++ib)
#pragma unroll
                for (int ks = 0; ks < 2; ++ks) {
                    const LAS unsigned char* pa = Ps + (ib * 16 + li) * RP_STRIDE + (32 * ks + 4 * g) * 2;
                    const bf16x8 a = cat8(*(const LAS s16x4*)pa, *(const LAS s16x4*)(pa + 32));
                    oacc[ib] = __builtin_amdgcn_mfma_f32_16x16x32_bf16(a, vfrag[ks], oacc[ib], 0, 0, 0);
                }
            {
                bf16_t* ob = OFB + ((size_t)dir * MT + rowbase) * EB + h * 512 + slice * 128 + w * 16 + li;
#pragma unroll
                for (int ib = 0; ib < 4; ++ib)
#pragma unroll
                    for (int r = 0; r < 4; ++r) { const unsigned pk2 = cvt_pk_bf16(oacc[ib][r], 0.f); ob[(size_t)(ib * 16 + 4 * g + r) * EB] = (bf16_t)(pk2 & 0xffffu); }
            }
        }
#undef RET_LOAD
#undef RET_ROWBASE
    }
}
__device__ __forceinline__ void ret_phaseB(const Params& p) {
    unsigned char* ws_ = opq(p.ws);
    const int tid = opaque_tid(), lane = tid & 63, wave = tid >> 6;
    const int gw = blockIdx.x * 8 + wave, NGW = gridDim.x * 8;
    const bf16_t* PROJ = (const bf16_t*)(ws_ + WS_PROJ);
    const bf16_t* OFB = (const bf16_t*)(ws_ + WS_OFB);
    bf16_t* GATED = (bf16_t*)(ws_ + WS_GATED);
    for (int it0 = gw * 6; it0 < MT * 8; it0 += NGW * 6) {
        u32x4 of[6], ob[6], gg[6];
#pragma unroll
        for (int q = 0; q < 6; ++q) { const int item = it0 + q; const int m = item >> 3, h = item & 7; const size_t off = (size_t)m * EB + h * 512 + lane * 8;
            of[q] = *(const u32x4*)(OFB + off); ob[q] = *(const u32x4*)(OFB + (size_t)MT * EB + off); gg[q] = *(const u32x4*)(PROJ + (size_t)m * NP_RET + 8192 + h * 512 + lane * 8); }
#pragma unroll
        for (int q = 0; q < 6; ++q) { const int item = it0 + q; const int m = item >> 3, h = item & 7; const size_t off = (size_t)m * EB + h * 512 + lane * 8;
            float o[8]; float ss = 0.f;
#pragma unroll
            for (int e = 0; e < 4; ++e) { o[2 * e] = bf_lo(of[q][e]) + bf_lo(ob[q][e]); o[2 * e + 1] = bf_hi(of[q][e]) + bf_hi(ob[q][e]); ss += o[2 * e] * o[2 * e] + o[2 * e + 1] * o[2 * e + 1]; }
            ss = wave_sum(ss);
            const float rn = 1.0f / sqrtf(ss * (1.0f / 512.0f) + EPS);
            u32x4 r;
#pragma unroll
            for (int e = 0; e < 4; ++e) { const float g0 = bf_lo(gg[q][e]), g1 = bf_hi(gg[q][e]); r[e] = cvt_pk_bf16(silu_f(g0) * o[2 * e] * rn, silu_f(g1) * o[2 * e + 1] * rn); }
            *(u32x4*)(GATED + off) = r; }
    }
}

constexpr int NA_KSTR = 272, NA_VSTR = 288, NA_VOFF = 17408, NA_BUF = 35840, NA_RPB = 71680, NA_QOFF = 73728, NA_QW = 8704;
constexpr float LOG2E = 1.4426950408889634f;
struct NaQ { f32x4 o[8]; float m, l, pend; };
__device__ __forceinline__ bf16x8 na_softmax(const f32x4 s0, const f32x4 s1, NaQ& q, const bool first) {
    const float x = fmaxf(fmaxf(fmaxf(s0[0], s0[1]), fmaxf(s0[2], s0[3])), fmaxf(fmaxf(s1[0], s1[1]), fmaxf(s1[2], s1[3])));
    const float xa = __shfl_xor(x, 16), xb = __shfl_xor(x, 32), xc = __shfl_xor(x, 48);
    if (first) { const float tmax = fmaxf(fmaxf(x, xa), fmaxf(xb, xc)); q.m = tmax; q.pend = tmax; }
    else {
        const bool need = q.pend > q.m + 8.0f;
        if (__builtin_amdgcn_ballot_w64(need) != 0ull) {
            const float mnew = need ? q.pend : q.m; const float alpha = __builtin_amdgcn_exp2f(q.m - mnew);
#pragma unroll
            for (int db = 0; db < 8; ++db) q.o[db] = q.o[db] * alpha;
            q.l *= alpha; q.m = mnew;
        }
    }
    f32x4 p0, p1;
#pragma unroll
    for (int rr = 0; rr < 4; ++rr) { p0[rr] = __builtin_amdgcn_exp2f(s0[rr] - q.m); p1[rr] = __builtin_amdgcn_exp2f(s1[rr] - q.m); }
    q.l += ((p0[0] + p0[1]) + (p0[2] + p0[3])) + ((p1[0] + p1[1]) + (p1[2] + p1[3]));
    const bf16x8 pf = pack8(p0, p1);
    if (!first) q.pend = fmaxf(q.pend, fmaxf(fmaxf(x, xa), fmaxf(xb, xc)));
    return pf;
}
__device__ __forceinline__ void na_group2(const bool f0, const bool f1, const LAS unsigned char* Qw, LAS unsigned char* Kb, LAS unsigned char* Vb, int cb, bool local, int rb0, const LAS float* rpbs, float sc2,
                                          unsigned vmask, int cbase, NaQ& q0, NaQ& q1, int li, int g, int tq, int tp) {
    f32x4 s00 = (f32x4){0.f, 0.f, 0.f, 0.f}, s01 = s00, s10 = s00, s11 = s00;
#pragma unroll
    for (int kk = 0; kk < 4; ++kk) {
        const bf16x8 ka = *(const LAS bf16x8*)(Kb + (cb + li) * NA_KSTR + (kk * 32 + 8 * g) * 2);
        const bf16x8 kb = *(const LAS bf16x8*)(Kb + (cb + 16 + li) * NA_KSTR + (kk * 32 + 8 * g) * 2);
        const bf16x8 qa = *(const LAS bf16x8*)(Qw + li * NA_KSTR + (kk * 32 + 8 * g) * 2);
        const bf16x8 qb2 = *(const LAS bf16x8*)(Qw + (16 + li) * NA_KSTR + (kk * 32 + 8 * g) * 2);
        s00 = __builtin_amdgcn_mfma_f32_16x16x32_bf16(ka, qa, s00, 0, 0, 0); s01 = __builtin_amdgcn_mfma_f32_16x16x32_bf16(kb, qa, s01, 0, 0, 0);
        s10 = __builtin_amdgcn_mfma_f32_16x16x32_bf16(ka, qb2, s10, 0, 0, 0); s11 = __builtin_amdgcn_mfma_f32_16x16x32_bf16(kb, qb2, s11, 0, 0, 0);
    }
    s00 = s00 * sc2; s01 = s01 * sc2; s10 = s10 * sc2; s11 = s11 * sc2;
    if (local) { const int rb1 = rb0 - 31;
#pragma unroll
        for (int k = 0; k < 4; ++k) { const bool v0 = (vmask >> k) & 1u, v1 = (vmask >> (k + 4)) & 1u;
            const int c0 = min(max(cbase + k, 0), 30), c1 = min(max(cbase + 16 + k, 0), 30);
            float b00 = rpbs[rb0 + c0], b01 = rpbs[rb0 + c1], b10 = rpbs[rb1 + c0], b11 = rpbs[rb1 + c1];
            asm volatile("" : "+v"(b00), "+v"(b01), "+v"(b10), "+v"(b11));
            s00[k] = v0 ? s00[k] + b00 : -INFINITY; s01[k] = v1 ? s01[k] + b01 : -INFINITY;
            s10[k] = v0 ? s10[k] + b10 : -INFINITY; s11[k] = v1 ? s11[k] + b11 : -INFINITY; } }
    const bf16x8 pf0 = na_softmax(s00, s01, q0, f0);
    const bf16x8 pf1 = na_softmax(s10, s11, q1, f1);
    LAS unsigned char* va0 = Vb + (cb + 4 * g + tq) * NA_VSTR + (4 * tp) * 2;
    bf16x8 an0 = cat8(tr_read(va0), tr_read(va0 + 16 * NA_VSTR));
    bf16x8 an1 = cat8(tr_read(va0 + 32), tr_read(va0 + 32 + 16 * NA_VSTR));
    bf16x8 an2 = cat8(tr_read(va0 + 64), tr_read(va0 + 64 + 16 * NA_VSTR));
#pragma unroll
    for (int db = 0; db < 8; ++db) {
        const bf16x8 a = an0; an0 = an1; an1 = an2;
        if (db + 3 < 8) { LAS unsigned char* va = va0 + (db + 3) * 32; an2 = cat8(tr_read(va), tr_read(va + 16 * NA_VSTR)); }
        q0.o[db] = __builtin_amdgcn_mfma_f32_16x16x32_bf16(a, pf0, q0.o[db], 0, 0, 0);
        q1.o[db] = __builtin_amdgcn_mfma_f32_16x16x32_bf16(a, pf1, q1.o[db], 0, 0, 0);
        __builtin_amdgcn_sched_barrier(0);
    }
}
__device__ __forceinline__ void na_group1(const bool f, const LAS unsigned char* Qw, LAS unsigned char* Kb, LAS unsigned char* Vb, int cb, int rb, const LAS float* rpbs, float sc2,
                                          unsigned vmask, int cbase, NaQ& q, int li, int g, int tq, int tp) {
    f32x4 s0 = (f32x4){0.f, 0.f, 0.f, 0.f}, s1 = s0;
#pragma unroll
    for (int kk = 0; kk < 4; ++kk) {
        const bf16x8 ka = *(const LAS bf16x8*)(Kb + (cb + li) * NA_KSTR + (kk * 32 + 8 * g) * 2);
        const bf16x8 kb = *(const LAS bf16x8*)(Kb + (cb + 16 + li) * NA_KSTR + (kk * 32 + 8 * g) * 2);
        const bf16x8 qa = *(const LAS bf16x8*)(Qw + li * NA_KSTR + (kk * 32 + 8 * g) * 2);
        s0 = __builtin_amdgcn_mfma_f32_16x16x32_bf16(ka, qa, s0, 0, 0, 0); s1 = __builtin_amdgcn_mfma_f32_16x16x32_bf16(kb, qa, s1, 0, 0, 0);
    }
    s0 = s0 * sc2; s1 = s1 * sc2;
#pragma unroll
    for (int k = 0; k < 4; ++k) { const bool v0 = (vmask >> k) & 1u, v1 = (vmask >> (k + 4)) & 1u;
        const int c0 = min(max(cbase + k, 0), 30), c1 = min(max(cbase + 16 + k, 0), 30);
        float b0 = rpbs[rb + c0], b1 = rpbs[rb + c1]; asm volatile("" : "+v"(b0), "+v"(b1));
        s0[k] = v0 ? s0[k] + b0 : -INFINITY; s1[k] = v1 ? s1[k] + b1 : -INFINITY; }
    const bf16x8 pf = na_softmax(s0, s1, q, f);
    LAS unsigned char* va0 = Vb + (cb + 4 * g + tq) * NA_VSTR + (4 * tp) * 2;
    bf16x8 an0 = cat8(tr_read(va0), tr_read(va0 + 16 * NA_VSTR));
    bf16x8 an1 = cat8(tr_read(va0 + 32), tr_read(va0 + 32 + 16 * NA_VSTR));
#pragma unroll
    for (int db = 0; db < 8; ++db) {
        const bf16x8 a = an0; an0 = an1;
        if (db + 2 < 8) { LAS unsigned char* va = va0 + (db + 2) * 32; an1 = cat8(tr_read(va), tr_read(va + 16 * NA_VSTR)); }
        q.o[db] = __builtin_amdgcn_mfma_f32_16x16x32_bf16(a, pf, q.o[db], 0, 0, 0);
        __builtin_amdgcn_sched_barrier(0);
    }
}
__device__ __forceinline__ void na_phase(const Params& p, int j, bool with_ctx, LAS unsigned char* lds) {
    unsigned char* ws_ = opq(p.ws);
    const int tid = opaque_tid(), lane = tid & 63, w = __builtin_amdgcn_readfirstlane(tid >> 6), g = lane >> 4, li = lane & 15;
    const int tq = li >> 2, tp = li & 3;
    const bf16_t* PROJ = (const bf16_t*)(ws_ + WS_PROJ);
    bf16_t* GATED = (bf16_t*)(ws_ + WS_GATED);
    LAS float* rpbs = (LAS float*)(lds + NA_RPB);
    const float sc2 = 0.08838834764831845f * LOG2E;
    const int NU = 1024 + (with_ctx ? 128 : 0);
    for (int u = blockIdx.x; u < NU; u += gridDim.x) {
        const bool isctx = u >= 1024;
        int b, head, qb = 0, r0 = 0, rs0 = 0, nloc = 0, qrow0, qrow1, rsw0 = 0, rsw1 = 0;
        if (!isctx) {
            const int rnd = u / (int)gridDim.x, bx = u - rnd * (int)gridDim.x; const int grp = (gridDim.x == 256) ? rnd * 32 + (bx & 7) * 4 + (bx >> 6) : (u >> 3);
            const int rq = (gridDim.x == 256) ? ((bx >> 3) & 7) : (u & 7); b = grp >> 5; head = grp & 31; qb = w & 3; r0 = 4 * rq + 2 * (w >> 2);
            qrow0 = b * SEQ + r0 * 64 + qb * 16; qrow1 = qrow0 + 64; rsw0 = min(max(r0 - 4, 0), 24); rsw1 = min(max(r0 - 3, 0), 24);
            rs0 = min(max(4 * rq - 4, 0), 24); nloc = min(max(4 * rq - 1, 0), 24) + 8 - rs0; }
        else { const int v = u - 1024; b = v >> 5; head = v & 31; qrow0 = ML + b * CTXL + w * 16; qrow1 = qrow0 + 128; }
        const int nit = nloc + 4;
        const int cb_loc = (qb == 0) ? 0 : (qb == 1) ? 8 : (qb == 2) ? 24 : 32;
        if (tid < 465) rpbs[tid] = opq(p.na_rpb)[(size_t)(j * 32 + head) * 465 + tid] * LOG2E;
        unsigned vmask = 0; const int cbase = cb_loc + 4 * g - (qb * 16 + li) + 15;
        { const int qc = qb * 16 + li; const int wsx = min(max(qc - 8, 0), 48);
#pragma unroll
          for (int k = 0; k < 8; ++k) { const int kc = cb_loc + (k >> 2) * 16 + 4 * g + (k & 3); vmask |= ((kc >= wsx) && (kc < wsx + 16)) ? (1u << k) : 0u; } }
        NaQ q0, q1;
        LAS unsigned char* Qw = lds + NA_QOFF + w * NA_QW;
#pragma unroll
        for (int db = 0; db < 8; ++db) { q0.o[db] = (f32x4){0.f, 0.f, 0.f, 0.f}; q1.o[db] = (f32x4){0.f, 0.f, 0.f, 0.f}; }
        q0.m = 0.f; q1.m = 0.f; q0.l = 0.f; q1.l = 0.f; q0.pend = 0.f; q1.pend = 0.f;
        u32x4 pA[2][2];
#define NA_LOAD(it, R) do { const int trow_ = ((it) < nloc) ? b * SEQ + (rs0 + (it)) * 64 : ML + b * CTXL + ((it) - nloc) * 64; _Pragma("unroll") for (int t = 0; t < 2; ++t) { const int idx = tid + 512 * t; \
        const bf16_t* sp = PROJ + (size_t)(trow_ + (idx >> 4)) * NP_NA + 4096 + head * 128 + (idx & 15) * 8; R[t][0] = *(const u32x4*)sp; R[t][1] = *(const u32x4*)(sp + 4096); } } while (0)
#define NA_STORE(buf, R) do { _Pragma("unroll") for (int t = 0; t < 2; ++t) { const int idx = tid + 512 * t; LAS unsigned char* dp = lds + (buf) * NA_BUF; \
        *(LAS u32x4*)(dp + (idx >> 4) * NA_KSTR + (idx & 15) * 16) = R[t][0]; *(LAS u32x4*)(dp + NA_VOFF + (idx >> 4) * NA_VSTR + (idx & 15) * 16) = R[t][1]; } } while (0)
        {
            u32x4 qv[8];
#pragma unroll
            for (int i = 0; i < 8; ++i) { const int c = lane + 64 * i, row = c >> 4, ch = c & 15;
                qv[i] = *(const u32x4*)(PROJ + (size_t)((row < 16 ? qrow0 : qrow1) + (row & 15)) * NP_NA + head * 128 + ch * 8); }
            NA_LOAD(0, pA);
#pragma unroll
            for (int i = 0; i < 8; ++i) { const int c = lane + 64 * i, row = c >> 4, ch = c & 15; *(LAS u32x4*)(Qw + row * NA_KSTR + ch * 16) = qv[i]; }
            NA_STORE(0, pA);
        }
        __syncthreads();
        for (int it = 0; it < nit; ++it) {
            const int cur = it & 1;
            if (it + 1 < nit) NA_LOAD(it + 1, pA);
            const bool local = it < nloc; const int kr = rs0 + it;
            LAS unsigned char* Kb = lds + cur * NA_BUF; LAS unsigned char* Vb = Kb + NA_VOFF;
            if (local) {
                const bool act0 = (kr >= rsw0 && kr < rsw0 + 8), act1 = (kr >= rsw1 && kr < rsw1 + 8); const int rb0 = (kr - r0 + 7) * 31;
                if (act0 && act1) na_group2(kr == rsw0, kr == rsw1, Qw, Kb, Vb, cb_loc, true, rb0, rpbs, sc2, vmask, cbase, q0, q1, li, g, tq, tp);
                else if (act0) na_group1(kr == rsw0, Qw, Kb, Vb, cb_loc, rb0, rpbs, sc2, vmask, cbase, q0, li, g, tq, tp);
                else if (act1) na_group1(kr == rsw1, Qw + 16 * NA_KSTR, Kb, Vb, cb_loc, rb0 - 31, rpbs, sc2, vmask, cbase, q1, li, g, tq, tp);
            } else {
                const bool f_ = isctx && it == 0;
                for (int gi = 0; gi < 2; ++gi) na_group2(f_ && gi == 0, f_ && gi == 0, Qw, Kb, Vb, gi * 32, false, 0, rpbs, sc2, vmask, cbase, q0, q1, li, g, tq, tp);
            }
            if (it + 1 < nit) NA_STORE(cur ^ 1, pA);
            __syncthreads();
        }
#undef NA_LOAD
#undef NA_STORE
        {
            u32x2 ggv[2][8];
#pragma unroll
            for (int t = 0; t < 2; ++t) { const size_t row = (size_t)((t ? qrow1 : qrow0) + li);
#pragma unroll
                for (int db = 0; db < 8; ++db) ggv[t][db] = *(const u32x2*)(PROJ + row * NP_NA + 12288 + head * 128 + db * 16 + 4 * g); }
#pragma unroll
            for (int t = 0; t < 2; ++t) {
                float lt = t ? q1.l : q0.l; lt += __shfl_xor(lt, 16); lt += __shfl_xor(lt, 32);
                const float inv = 1.0f / lt; const size_t row = (size_t)((t ? qrow1 : qrow0) + li);
#pragma unroll
                for (int db = 0; db < 8; ++db) { const int d = db * 16 + 4 * g; const f32x4 ov = t ? q1.o[db] : q0.o[db]; const u32x2 gg = ggv[t][db];
                    u32x2 wv; wv.x = cvt_pk_bf16(ov[0] * inv * silu_f(bf_lo(gg.x)), ov[1] * inv * silu_f(bf_hi(gg.x)));
                    wv.y = cvt_pk_bf16(ov[2] * inv * silu_f(bf_lo(gg.y)), ov[3] * inv * silu_f(bf_hi(gg.y)));
                    *(u32x2*)(GATED + row * EB + head * 128 + d) = wv; }
            }
        }
    }
}

#define XB_TMO      128
#define XB_XCNT(j)  (256  + 64 * (j))
#define XB_XSUB(j)  (1280 + 64 * (j))
#define XB_XGEN(j)  (2304 + 64 * (j))
#define XB_TOP      3328
#define XB_TOPGEN   3392
#define XCD_BAR_WORDS 3456
#define XB_SPIN_CAP (1u << 20)
__device__ __forceinline__ unsigned xb_ld(unsigned* p)              { return __hip_atomic_load(p, __ATOMIC_RELAXED, __HIP_MEMORY_SCOPE_AGENT); }
__device__ __forceinline__ unsigned xb_add(unsigned* p, unsigned v) { return __hip_atomic_fetch_add(p, v, __ATOMIC_RELAXED, __HIP_MEMORY_SCOPE_AGENT); }
__device__ __forceinline__ unsigned xb_xcc_id() { return (unsigned)__builtin_amdgcn_s_getreg((3 << 11) | 20) & 0xFu; }
#define XB_SPIN(cond, bar) do { unsigned _sp = 0; while (cond) { __builtin_amdgcn_s_sleep(1); \
    if ((++_sp & 255u) == 0u) { if (xb_ld(&(bar)[XB_TMO])) break; if (_sp > XB_SPIN_CAP) { atomicAdd(&(bar)[XB_TMO], 1u); break; } } } } while (0)
struct XcdBarrier { unsigned* bar; unsigned x; volatile LAS unsigned* st; };
__device__ __forceinline__ XcdBarrier xcd_barrier_post(unsigned* bar, volatile LAS unsigned* st) {
    XcdBarrier b; b.bar = bar; b.x = xb_xcc_id(); b.st = st;
    if (threadIdx.x == 0) (void)xb_add(&bar[XB_XCNT(b.x)], 1u);
    return b;
}
__device__ __forceinline__ void xcd_barrier_complete(unsigned* bar, unsigned x, unsigned& nloc, unsigned& nx) {
    const unsigned G = gridDim.x * gridDim.y * gridDim.z;
    unsigned sum, cnt, mine, sp = 0u;
    for (;;) {
        sum = 0u; cnt = 0u; mine = 0u;
#pragma unroll
        for (unsigned j = 0; j < 16; ++j) { const unsigned c = xb_ld(&bar[XB_XCNT(j)]); sum += c; cnt += (c > 0u) ? 1u : 0u; mine = (j == x) ? c : mine; }
        if (sum == G) break;
        __builtin_amdgcn_s_sleep(1);
        if ((++sp & 255u) == 0u) { if (xb_ld(&bar[XB_TMO])) break; if (sp > XB_SPIN_CAP) { atomicAdd(&bar[XB_TMO], 1u); break; } }
    }
    nloc = mine > 0u ? mine : 1u; nx = cnt > 0u ? cnt : 1u;
}
__device__ __forceinline__ void xcd_barrier(const XcdBarrier& b) {
    asm volatile("s_waitcnt vmcnt(0)" ::: "memory");
    __syncthreads();
    if (threadIdx.x == 0) {
        unsigned* bar = b.bar;
        __builtin_amdgcn_s_waitcnt(0);
        unsigned nloc = b.st[0], nx = b.st[1];
        if (nloc == 0u) { xcd_barrier_complete(bar, b.x, nloc, nx); b.st[0] = nloc; b.st[1] = nx; }
        const unsigned old = xb_add(&bar[XB_XSUB(b.x)], 1u);
        const unsigned gen = old / nloc;
        if (old + 1u == (gen + 1u) * nloc) {
            __builtin_amdgcn_fence(__ATOMIC_RELEASE, "agent");
            asm volatile("s_waitcnt vmcnt(0)" ::: "memory");
            const unsigned og = xb_add(&bar[XB_TOP], 1u);
            const unsigned tg = og / nx;
            if (og + 1u == (tg + 1u) * nx) xb_add(&bar[XB_TOPGEN], 1u);
            else XB_SPIN(xb_ld(&bar[XB_TOPGEN]) == tg, bar);
            __builtin_amdgcn_fence(__ATOMIC_ACQUIRE, "agent");
            xb_add(&bar[XB_XGEN(b.x)], 1u);
            asm volatile("s_waitcnt vmcnt(0)" ::: "memory");
        } else {
            XB_SPIN(xb_ld(&bar[XB_XGEN(b.x)]) == gen, bar);
            __builtin_amdgcn_fence(__ATOMIC_ACQUIRE, "agent");
            asm volatile("s_waitcnt vmcnt(0)" ::: "memory");
        }
    }
    __syncthreads();
}

__global__ void __launch_bounds__(512, 2) fwd_megakernel(Params p) {
    extern __shared__ __attribute__((aligned(16))) unsigned char smem[];
    LAS unsigned char* lds = (LAS unsigned char*)smem;
    cg::grid_group grid = cg::this_grid();
    unsigned* barw = (unsigned*)(opq(p.ws) + WS_BAR);
    volatile LAS unsigned* bst = (volatile LAS unsigned*)(lds + LDS_BYTES - 64);
    if (blockIdx.x == 0) for (int i = threadIdx.x; i < XCD_BAR_WORDS; i += 512) barw[i] = 0u;
    if (threadIdx.x < 2) bst[threadIdx.x] = 0u;
#ifndef NO_PRO
    prologue(p, lds);
#endif
    grid.sync();
    const XcdBarrier xbar = xcd_barrier_post(barw, bst);
#define GSYNC() xcd_barrier(xbar)
    const bf16_t* H = (const bf16_t*)(opq(p.ws) + WS_H);
    bf16_t* PROJ = (bf16_t*)(opq(p.ws) + WS_PROJ);
    const bf16_t* GATED = (const bf16_t*)(opq(p.ws) + WS_GATED);
    float* XS = (float*)(opq(p.ws) + WS_XS);
    for (int l = 0; l < 4; ++l) {
        const int j = l >> 1; const bool isna = (l & 1) != 0;
        norm_phase(p, l);
        GSYNC();
        {
            const int N = isna ? NP_NA : NP_RET;
            const bf16_t* Bt = (const bf16_t*)(opq(p.ws) + (isna ? (j ? WS_WNI1 : WS_WNI0) : (j ? WS_WRI1 : WS_WRI0)));
            pg8::Gemm gm{H, Bt, MT, N, DM, DM}; pg8::StaticOrder S; S.init(MT, N, (int)gridDim.x, (int)blockIdx.x);
            pg8::EpiBf16 E{PROJ, N};
#ifndef NO_G1
            pg8::gemm_phase<pg8::EpiBf16, pg8::StaticOrder>(lds, gm, S, E);
#endif
        }
        GSYNC();
#ifndef NO_RETA
        if (!isna) { ret_phaseA(p, j, lds); GSYNC(); ret_phaseB(p); }
#endif
#ifndef NO_NA
        if (isna) na_phase(p, j, l != 3, lds);
#endif
        GSYNC();
        {
            const bf16_t* Bt = (const bf16_t*)(opq(p.ws) + (isna ? (j ? WS_WNO1 : WS_WNO0) : (j ? WS_WRO1 : WS_WRO0)));
            {
                pg8::Gemm gm{GATED, Bt, ML, DM, EB, EB}; pg8::StaticOrder S; S.init(ML, DM, (int)gridDim.x, (int)blockIdx.x);
                pg8::EpiResid E{(l == 0) ? (const float*)opq(p.x) : (const float*)XS, XS, (const float*)(opq(p.ws) + WS_MODV) + (size_t)l * 5 * 6144 + 4096};
                pg8::gemm_phase<pg8::EpiResid, pg8::StaticOrder>(lds, gm, S, E);
            }
            if (l != 3) {
                pg8::Gemm gm{GATED + (size_t)ML * EB, Bt, MC, DM, EB / 8, EB}; pg8::SplitOrder S; S.init(MC, DM, 8, (int)gridDim.x, (int)blockIdx.x);
                pg8::EpiPartial E{(float*)(opq(p.ws) + WS_PART), MC, DM};
                pg8::gemm_phase<pg8::EpiPartial, pg8::SplitOrder>(lds, gm, S, E);
            }
        }
        GSYNC();
    }
    final_norm(p);
}

extern "C" void kernel_launch(void* const* d_in, const int* in_sizes, int n_in, void* d_out, int out_size, void* d_ws, size_t ws_size, hipStream_t stream) {
    static int grid_blocks = 0;
    if (grid_blocks == 0) {
        if (ws_size < WS_END) { fprintf(stderr, "kernel_launch: workspace too small (%zu < %zu)\n", ws_size, (size_t)WS_END); grid_blocks = -1; return; }
        int dev = 0, cus = 0, per_cu = 0;
        hipGetDevice(&dev);
        hipDeviceGetAttribute(&cus, hipDeviceAttributeMultiprocessorCount, dev);
        if (hipFuncSetAttribute((const void*)fwd_megakernel, hipFuncAttributeMaxDynamicSharedMemorySize, LDS_BYTES) != hipSuccess) { fprintf(stderr, "kernel_launch: hipFuncSetAttribute failed\n"); }
        if (hipOccupancyMaxActiveBlocksPerMultiprocessor(&per_cu, (const void*)fwd_megakernel, 512, LDS_BYTES) != hipSuccess || per_cu < 1) { fprintf(stderr, "kernel_launch: occupancy query says %d\n", per_cu); per_cu = 1; }
        (void)hipGetLastError();
        grid_blocks = cus * 1;
        if (grid_blocks <= 0) grid_blocks = 256;
    }
    if (grid_blocks < 0) return;
    Params p{};
    p.x = (const float*)d_in[0]; p.c = (const float*)d_in[1]; p.ctx = (const float*)d_in[2]; p.c_ctx = (const float*)d_in[3];
    p.mod_w = (const float*)d_in[4]; p.mod_b = (const float*)d_in[5]; p.norm_g = (const float*)d_in[6]; p.ret_w_in = (const float*)d_in[7];
    p.ret_df = (const float*)d_in[8]; p.ret_db = (const float*)d_in[9]; p.ret_w_out = (const float*)d_in[10]; p.na_w_in = (const float*)d_in[11];
    p.na_rpb = (const float*)d_in[12]; p.na_w_out = (const float*)d_in[13]; p.final_g = (const float*)d_in[14];
    p.out = (float*)d_out; p.ws = (unsigned char*)d_ws;
    void* args[] = {&p};
    hipError_t e = hipLaunchCooperativeKernel((const void*)fwd_megakernel, dim3(grid_blocks), dim3(512), args, LDS_BYTES, stream);
    if (e != hipSuccess) fprintf(stderr, "cooperative launch failed: %s (grid %d)\n", hipGetErrorString(e), grid_blocks);
}
```

```cpp
#include <hip/hip_runtime.h>
#include <hip/hip_cooperative_groups.h>
#include <cstdio>
namespace cg = cooperative_groups;

#define LAS __attribute__((address_space(3)))
typedef unsigned short bf16_t;
typedef short bf16x8 __attribute__((ext_vector_type(8)));
typedef short s16x4 __attribute__((ext_vector_type(4)));
typedef float f32x4 __attribute__((ext_vector_type(4)));
typedef float f32x2 __attribute__((ext_vector_type(2)));
typedef unsigned u32x4 __attribute__((ext_vector_type(4)));
typedef unsigned u32x2 __attribute__((ext_vector_type(2)));

constexpr int DM = 2048, NB = 4, SEQ = 2048, CTXL = 256, EB = 4096;
constexpr int ML = NB * SEQ, MC = NB * CTXL, MT = ML + MC;
constexpr int NP_RET = 12288, NP_NA = 16384;
constexpr float EPS = 1e-6f;

constexpr size_t MiB = 1u << 20;
constexpr size_t WS_WRI0 = 0, WS_WRI1 = 48 * MiB, WS_WNI0 = 96 * MiB, WS_WNI1 = 160 * MiB;
constexpr size_t WS_WRO0 = 224 * MiB, WS_WRO1 = 240 * MiB, WS_WNO0 = 256 * MiB, WS_WNO1 = 272 * MiB;
constexpr size_t WS_MODV = 288 * MiB, WS_ROPE = 289 * MiB, WS_XS = 290 * MiB, WS_H = 362 * MiB;
constexpr size_t WS_PROJ = 398 * MiB, WS_GATED = 686 * MiB, WS_OFB = 758 * MiB, WS_PART = 902 * MiB, WS_BAR = 966 * MiB, WS_END = 967 * MiB;

constexpr int LDS_BYTES = 147456;

struct Params {
    const float *x, *c, *ctx, *c_ctx, *mod_w, *mod_b, *norm_g, *ret_w_in, *ret_df, *ret_db, *ret_w_out, *na_w_in, *na_rpb, *na_w_out, *final_g;
    float* out; unsigned char* ws;
};

__device__ __forceinline__ unsigned cvt_pk_bf16(float lo, float hi) { unsigned r; asm volatile("v_cvt_pk_bf16_f32 %0, %1, %2" : "=v"(r) : "v"(lo), "v"(hi)); return r; }
__device__ __forceinline__ float bf_lo(unsigned u) { return __uint_as_float(u << 16); }
__device__ __forceinline__ float bf_hi(unsigned u) { return __uint_as_float(u & 0xffff0000u); }
__device__ __forceinline__ float wave_sum(float v) {
#pragma unroll
    for (int o = 1; o < 64; o <<= 1) v += __shfl_xor(v, o);
    return v;
}
__device__ __forceinline__ int opaque_tid() { int t = threadIdx.x; asm volatile("" : "+v"(t)); return t; }
template <class T> __device__ __forceinline__ T* opq(T* q) { __attribute__((address_space(1))) T* g = (__attribute__((address_space(1))) T*)q; asm volatile("" : "+s"(g)); return (T*)g; }
__device__ __forceinline__ float silu_f(float v) { return v / (1.0f + __expf(-v)); }
__device__ __forceinline__ s16x4 tr_read(LAS unsigned char* p) {
    typedef short v4i16_t __attribute__((ext_vector_type(4)));
    return __builtin_bit_cast(s16x4, __builtin_amdgcn_ds_read_tr16_b64_v4i16((LAS v4i16_t*)p));
}
__device__ __forceinline__ bf16x8 cat8(s16x4 lo, s16x4 hi) { const u32x2 a = __builtin_bit_cast(u32x2, lo), b = __builtin_bit_cast(u32x2, hi); u32x4 r; r.x = a.x; r.y = a.y; r.z = b.x; r.w = b.y; return __builtin_bit_cast(bf16x8, r); }
__device__ __forceinline__ bf16x8 pack8(f32x4 a, f32x4 b) {
    u32x4 w; w.x = cvt_pk_bf16(a[0], a[1]); w.y = cvt_pk_bf16(a[2], a[3]); w.z = cvt_pk_bf16(b[0], b[1]); w.w = cvt_pk_bf16(b[2], b[3]);
    return __builtin_bit_cast(bf16x8, w);
}

namespace pg8 {
constexpr int BM = 256, BK = 64, HALF = 128, HTB = HALF * BK * 2, STAGE_BYTES = 8 * HTB, NXCD = 8, WGM = 8;
__host__ __device__ __forceinline__ int lds_byte(int r, int c) { const int st = (r >> 4) * 2 + (c >> 5), rr = r & 15, cc = c & 31, ob = rr * 64 + cc * 2; return st * 1024 + (ob ^ (((ob >> 9) & 1) << 5)); }
__host__ __device__ __forceinline__ void stage_rc(int b, int& R, int& C) { const int st = b / 1024, sb = b % 1024, swz = sb ^ (((sb >> 9) & 1) << 5); R = (st >> 1) * 16 + swz / 64; C = (st & 1) * 32 + (swz % 64) / 2; }
__host__ __device__ __forceinline__ int perm32(int rho) { const int n = rho >> 4, i = rho & 15; return 8 * (i >> 2) + 4 * n + (i & 3); }

struct Unit { int pm, pn, ks; };
struct Gemm { const bf16_t* A; const bf16_t* Bt; int M, N, K, ld; };

struct StaticOrder {
    int nM, nN, nwg, G, c;
    __device__ void init(int M, int N, int G_, int c_) { nM = M / BM; nN = N / BM; nwg = nM * nN; G = G_; c = c_; }
    __device__ bool next(int i, Unit& u) const {
        const long L = (long)i * G + c; if (L >= nwg) return false;
        int wgid = (int)L; { const int q = nwg / NXCD, r = nwg % NXCD, xcd = wgid % NXCD, off = wgid / NXCD; wgid = (xcd < r ? xcd * (q + 1) : r * (q + 1) + (xcd - r) * q) + off; }
        const int nig = WGM * nN, gid = wgid / nig, fm = gid * WGM, gsz = (nM - fm) < WGM ? (nM - fm) : WGM;
        u.pm = fm + ((wgid % nig) % gsz); u.pn = (wgid % nig) / gsz; u.ks = 0; return true;
    }
    __device__ __forceinline__ void a_ready(const Unit&) const {}
    __device__ __forceinline__ void done(const Unit&) const {}
};

struct SplitOrder {
    int nM, nN, nS, nwg, G, c;
    __device__ void init(int M, int N, int nS_, int G_, int c_) { nM = M / BM; nN = N / BM; nS = nS_; nwg = nM * nN * nS; G = G_; c = c_; }
    __device__ bool next(int i, Unit& u) const {
        const long L = (long)i * G + c; if (L >= nwg) return false;
        const int l = (int)L; u.ks = l % nS; const int t = l / nS; u.pm = t % nM; u.pn = t / nM; return true;
    }
    __device__ __forceinline__ void a_ready(const Unit&) const {}
    __device__ __forceinline__ void done(const Unit&) const {}
};
struct EpiPartial {
    static constexpr bool PERM = false;
    float* P; int rows, ldc;
    __device__ __forceinline__ void operator()(const f32x4 (&acc)[2][2][4][2], const Unit& u, int wr, int wc, int fr, int fq) const {
        const int row0 = u.pm * BM + wr * 64 + fr, col0 = u.pn * BM + wc * 32 + 4 * fq;
        float* base = P + (size_t)u.ks * rows * ldc;
#pragma unroll
        for (int ai = 0; ai < 2; ++ai)
#pragma unroll
            for (int m = 0; m < 4; ++m) { float* rowp = base + (size_t)(row0 + ai * HALF + m * 16) * ldc + col0;
#pragma unroll
                for (int bj = 0; bj < 2; ++bj)
#pragma unroll
                    for (int n = 0; n < 2; ++n) *(f32x4*)(rowp + bj * HALF + n * 16) = acc[ai][bj][m][n]; }
    }
};
struct EpiBf16 {
    static constexpr bool PERM = true;
    bf16_t* O; int ldc;
    __device__ __forceinline__ void operator()(const f32x4 (&acc)[2][2][4][2], const Unit& u, int wr, int wc, int fr, int fq) const {
        const int row0 = u.pm * BM + wr * 64 + fr; const int col0 = u.pn * BM + wc * 32 + 8 * fq;
#pragma unroll
        for (int ai = 0; ai < 2; ++ai)
#pragma unroll
            for (int m = 0; m < 4; ++m) { bf16_t* rowp = O + (size_t)(row0 + ai * HALF + m * 16) * ldc + col0;
#pragma unroll
                for (int bj = 0; bj < 2; ++bj) { const f32x4 v0 = acc[ai][bj][m][0], v1 = acc[ai][bj][m][1];
                    u32x4 w; w.x = cvt_pk_bf16(v0[0], v0[1]); w.y = cvt_pk_bf16(v0[2], v0[3]); w.z = cvt_pk_bf16(v1[0], v1[1]); w.w = cvt_pk_bf16(v1[2], v1[3]);
                    *(u32x4*)(rowp + bj * HALF) = w; } }
    }
};
struct EpiResid {
    static constexpr bool PERM = false;
    const float* xsrc; float* xout; const float* gt_base;
    __device__ __forceinline__ void operator()(const f32x4 (&acc)[2][2][4][2], const Unit& u, int wr, int wc, int fr, int fq) const {
        const int row0 = u.pm * BM + wr * 64 + fr, col0 = u.pn * BM + wc * 32 + 4 * fq;
        const int mrow = (u.pm * BM < ML) ? ((u.pm * BM) >> 11) : 4;
        const float* gt = gt_base + mrow * 6144;
        f32x4 gv[2][2];
#pragma unroll
        for (int bj = 0; bj < 2; ++bj)
#pragma unroll
            for (int n = 0; n < 2; ++n) gv[bj][n] = *(const f32x4*)(gt + col0 + bj * HALF + n * 16);
#pragma unroll
        for (int ai = 0; ai < 2; ++ai) {
            f32x4 xv[4][2][2];
#pragma unroll
            for (int m = 0; m < 4; ++m) { const float* sp = xsrc + (size_t)(row0 + ai * HALF + m * 16) * DM;
#pragma unroll
                for (int bj = 0; bj < 2; ++bj)
#pragma unroll
                    for (int n = 0; n < 2; ++n) xv[m][bj][n] = *(const f32x4*)(sp + col0 + bj * HALF + n * 16); }
#pragma unroll
            for (int m = 0; m < 4; ++m) { float* dp = xout + (size_t)(row0 + ai * HALF + m * 16) * DM;
#pragma unroll
                for (int bj = 0; bj < 2; ++bj)
#pragma unroll
                    for (int n = 0; n < 2; ++n) *(f32x4*)(dp + col0 + bj * HALF + n * 16) = xv[m][bj][n] + gv[bj][n] * acc[ai][bj][m][n]; }
        }
    }
};

template <class Epi, class Sched, bool ALIGN_EPI = true, bool SP2 = true>
__device__ __forceinline__ void gemm_phase(LAS unsigned char* lds, const Gemm g, const Sched& S, const Epi& E) {
    const int tid = opaque_tid(), wid = __builtin_amdgcn_readfirstlane(tid >> 6), lane = tid & 63, wr = wid >> 2, wc = wid & 3, fr = lane & 15, fq = lane >> 4;
    const int K = g.ld, nt = g.K / BK;
    unsigned voffA[2], voffB[2];
#pragma unroll
    for (int i = 0; i < 2; ++i) { int R, C; stage_rc(tid * 16 + i * 8192, R, C); const int Rb = Epi::PERM ? ((R & ~31) + perm32(R & 31)) : R;
        voffA[i] = (unsigned)(R * K + C) * 2u; voffB[i] = (unsigned)(Rb * K + C) * 2u; }
    const size_t kstep = (size_t)(BK * 2);
    const size_t hstep = (size_t)HALF * K * 2;
    const size_t tstep = 2 * hstep;
    const unsigned ldsw = (unsigned)wid * 1024u;
    const int aoff = lds_byte(wr * 64 + fr, fq * 8), boff = lds_byte(wc * 32 + fr, fq * 8);
#define PG8_SA(b, h) (((b) * 2 + (h)) * HTB)
#define PG8_SB(b, h) ((4 + (b) * 2 + (h)) * HTB)
#define PG8_STAGE(bufoff, gbase, voff) do { _Pragma("unroll") for (int _i = 0; _i < 2; ++_i) \
        __builtin_amdgcn_global_load_lds((const unsigned*)((const char*)(gbase) + (voff)[_i]), (LAS unsigned*)(lds + (bufoff) + ldsw + _i * 8192), 16, 0, 0); } while (0)
#define PG8_LDA(dst, b, h) do { _Pragma("unroll") for (int m = 0; m < 4; ++m) _Pragma("unroll") for (int k = 0; k < 2; ++k) dst[m][k] = *(const LAS bf16x8*)(lds + PG8_SA(b, h) + aoff + m * 2048 + k * 1024); } while (0)
#define PG8_LDB(dst, b, h) do { _Pragma("unroll") for (int n = 0; n < 2; ++n) _Pragma("unroll") for (int k = 0; k < 2; ++k) dst[n][k] = *(const LAS bf16x8*)(lds + PG8_SB(b, h) + boff + n * 2048 + k * 1024); } while (0)
#define PG8_MMA(ai, bj, At, Bt) do { __builtin_amdgcn_s_setprio(1); _Pragma("unroll") for (int m = 0; m < 4; ++m) _Pragma("unroll") for (int n = 0; n < 2; ++n) _Pragma("unroll") for (int k = 0; k < 2; ++k) \
        acc[ai][bj][m][n] = __builtin_amdgcn_mfma_f32_16x16x32_bf16(Bt[n][k], At[m][k], acc[ai][bj][m][n], 0, 0, 0); __builtin_amdgcn_s_setprio(0); } while (0)
#define PG8_WAIT_V(n) asm volatile("s_waitcnt vmcnt(" #n ")" ::: "memory")
#define PG8_WAIT_L(n) asm volatile("s_waitcnt lgkmcnt(" #n ")" ::: "memory")
#define PG8_BAR __builtin_amdgcn_s_barrier()
#define PG8_SCHED __builtin_amdgcn_sched_barrier(0)
    Unit cur, nxt; int ui = 0;
    if (!S.next(0, cur)) return;
    f32x4 acc[2][2][4][2];
#pragma unroll
    for (int a = 0; a < 2; ++a)
#pragma unroll
        for (int b = 0; b < 2; ++b)
#pragma unroll
            for (int m = 0; m < 4; ++m)
#pragma unroll
                for (int n = 0; n < 2; ++n) acc[a][b][m][n] = (f32x4){0.f, 0.f, 0.f, 0.f};
    bf16x8 At[4][2], B0[2][2], B1[2][2];
    const size_t ksb = (size_t)g.K * 2;
    const char* cA = (const char*)g.A + (size_t)cur.pm * tstep + cur.ks * ksb; const char* cB = (const char*)g.Bt + (size_t)cur.pn * tstep + cur.ks * ksb;
    S.a_ready(cur);
    if constexpr (SP2) {
        PG8_STAGE(PG8_SB(0, 0), cB, voffB); PG8_STAGE(PG8_SB(0, 1), cB + hstep, voffB); PG8_STAGE(PG8_SA(0, 0), cA, voffA); PG8_STAGE(PG8_SA(0, 1), cA + hstep, voffA);
        if (wr == 1) PG8_BAR;
        PG8_WAIT_V(2); PG8_BAR;
        PG8_STAGE(PG8_SB(1, 0), cB + kstep, voffB); PG8_STAGE(PG8_SA(1, 0), cA + kstep, voffA); PG8_STAGE(PG8_SB(1, 1), cB + hstep + kstep, voffB);
        PG8_WAIT_V(6); PG8_BAR;
    } else {
        PG8_STAGE(PG8_SB(0, 0), cB, voffB); PG8_STAGE(PG8_SA(0, 0), cA, voffA); PG8_STAGE(PG8_SB(0, 1), cB + hstep, voffB); PG8_STAGE(PG8_SA(0, 1), cA + hstep, voffA);
        if (wr == 1) PG8_BAR;
        PG8_WAIT_V(4); PG8_BAR;
        PG8_STAGE(PG8_SB(1, 0), cB + kstep, voffB); PG8_STAGE(PG8_SA(1, 0), cA + kstep, voffA); PG8_STAGE(PG8_SB(1, 1), cB + hstep + kstep, voffB);
        PG8_WAIT_V(6); PG8_BAR;
    }
    for (;;) {
        const bool has_next = S.next(ui + 1, nxt);
        const char* nA = has_next ? (const char*)g.A + (size_t)nxt.pm * tstep + nxt.ks * ksb : cA; const char* nB = has_next ? (const char*)g.Bt + (size_t)nxt.pn * tstep + nxt.ks * ksb : cB;
        for (int t = 0; t < nt; t += 2) {
            const bool last = (t == nt - 2);
            const char* a1 = cA + (size_t)(t + 1) * kstep;
            const char* a2 = last ? nA : cA + (size_t)(t + 2) * kstep; const char* b2 = last ? nB : cB + (size_t)(t + 2) * kstep;
            const char* a3 = a2 + kstep; const char* b3 = b2 + kstep;
            if (last && has_next) S.a_ready(nxt);
            if constexpr (SP2) {
            PG8_LDB(B0, 0, 0); PG8_LDB(B1, 0, 1); PG8_SCHED; PG8_LDA(At, 0, 0); PG8_STAGE(PG8_SA(1, 1), a1 + hstep, voffA);
            PG8_WAIT_V(8); PG8_WAIT_L(0); PG8_BAR; PG8_MMA(0, 0, At, B0); PG8_MMA(0, 1, At, B1); PG8_BAR; PG8_SCHED;
            PG8_LDA(At, 0, 1); PG8_STAGE(PG8_SB(0, 0), b2, voffB); PG8_STAGE(PG8_SB(0, 1), b2 + hstep, voffB); PG8_STAGE(PG8_SA(0, 0), a2, voffA);
            PG8_WAIT_V(8); PG8_WAIT_L(0); PG8_BAR; PG8_MMA(1, 0, At, B0); PG8_MMA(1, 1, At, B1); PG8_BAR; PG8_SCHED;
            PG8_LDB(B0, 1, 0); PG8_LDB(B1, 1, 1); PG8_SCHED; PG8_LDA(At, 1, 0); PG8_STAGE(PG8_SA(0, 1), a2 + hstep, voffA);
            PG8_WAIT_V(8); PG8_WAIT_L(0); PG8_BAR; PG8_MMA(0, 0, At, B0); PG8_MMA(0, 1, At, B1); PG8_BAR; PG8_SCHED;
            PG8_LDA(At, 1, 1); PG8_STAGE(PG8_SB(1, 0), b3, voffB); PG8_STAGE(PG8_SB(1, 1), b3 + hstep, voffB); PG8_STAGE(PG8_SA(1, 0), a3, voffA);
            PG8_WAIT_V(8); PG8_WAIT_L(0); PG8_BAR; PG8_MMA(1, 0, At, B0); PG8_MMA(1, 1, At, B1); PG8_BAR; PG8_SCHED;
            } else {
            PG8_LDB(B0, 0, 0); PG8_SCHED; PG8_LDA(At, 0, 0); PG8_STAGE(PG8_SA(1, 1), a1 + hstep, voffA);
            PG8_WAIT_L(8); PG8_BAR; PG8_WAIT_L(0); PG8_MMA(0, 0, At, B0); PG8_BAR; PG8_SCHED;
            PG8_LDB(B1, 0, 1); PG8_STAGE(PG8_SB(0, 0), b2, voffB);
            PG8_BAR; PG8_WAIT_L(0); PG8_MMA(0, 1, At, B1); PG8_BAR;
            PG8_LDA(At, 0, 1); PG8_STAGE(PG8_SA(0, 0), a2, voffA);
            PG8_BAR; PG8_WAIT_L(0); PG8_MMA(1, 0, At, B0); PG8_BAR; PG8_SCHED;
            PG8_STAGE(PG8_SB(0, 1), b2 + hstep, voffB);
            PG8_WAIT_V(6); PG8_BAR; PG8_MMA(1, 1, At, B1); PG8_BAR;
            PG8_LDB(B0, 1, 0); PG8_SCHED; PG8_LDA(At, 1, 0); PG8_STAGE(PG8_SA(0, 1), a2 + hstep, voffA);
            PG8_WAIT_L(8); PG8_BAR; PG8_WAIT_L(0); PG8_MMA(0, 0, At, B0); PG8_BAR; PG8_SCHED;
            PG8_LDB(B1, 1, 1); PG8_STAGE(PG8_SB(1, 0), b3, voffB);
            PG8_BAR; PG8_WAIT_L(0); PG8_MMA(0, 1, At, B1); PG8_BAR;
            PG8_LDA(At, 1, 1); PG8_STAGE(PG8_SA(1, 0), a3, voffA);
            PG8_BAR; PG8_WAIT_L(0); PG8_MMA(1, 0, At, B0); PG8_BAR; PG8_SCHED;
            PG8_STAGE(PG8_SB(1, 1), b3 + hstep, voffB);
            PG8_WAIT_V(6); PG8_BAR; PG8_MMA(1, 1, At, B1); PG8_BAR;
            }
        }
        if constexpr (ALIGN_EPI) { if (wr == 0) PG8_BAR; }
        E(acc, cur, wr, wc, fr, fq); S.done(cur);
        if (!has_next) break;
#pragma unroll
        for (int a = 0; a < 2; ++a)
#pragma unroll
            for (int b = 0; b < 2; ++b)
#pragma unroll
                for (int m = 0; m < 4; ++m)
#pragma unroll
                    for (int n = 0; n < 2; ++n) acc[a][b][m][n] = (f32x4){0.f, 0.f, 0.f, 0.f};
        cur = nxt; cA = nA; cB = nB; ++ui;
        if constexpr (ALIGN_EPI) { if (wr == 1) PG8_BAR; }
    }
    PG8_WAIT_V(0);
    if constexpr (!ALIGN_EPI) { if (wr == 0) PG8_BAR; }
    PG8_BAR;
#undef PG8_SA
#undef PG8_SB
#undef PG8_STAGE
#undef PG8_LDA
#undef PG8_LDB
#undef PG8_MMA
#undef PG8_WAIT_V
#undef PG8_WAIT_L
#undef PG8_BAR
#undef PG8_SCHED
}
}

__device__ __forceinline__ void transpose_item(const float* W, int K, int N, bf16_t* WT, LAS float* scr, int item, int lane) {
    const int nblk = N >> 6, kb = item / nblk, nb = item - kb * nblk, k0 = kb * 64, n0 = nb * 64;
    const float* src = W + (size_t)k0 * N + n0 + lane;
#pragma unroll 16
    for (int i = 0; i < 64; ++i) scr[i * 65 + lane] = __builtin_nontemporal_load(src + (size_t)i * N);
    asm volatile("s_waitcnt lgkmcnt(0)" ::: "memory");
    const int c = lane & 7;
#pragma unroll
    for (int j = 0; j < 8; ++j) { const int n = (lane >> 3) + 8 * j; const LAS float* s = scr + (8 * c) * 65 + n;
        u32x4 o; o.x = cvt_pk_bf16(s[0], s[65]); o.y = cvt_pk_bf16(s[2 * 65], s[3 * 65]); o.z = cvt_pk_bf16(s[4 * 65], s[5 * 65]); o.w = cvt_pk_bf16(s[6 * 65], s[7 * 65]);
        *(u32x4*)(WT + (size_t)(n0 + n) * K + k0 + 8 * c) = o; }
    asm volatile("s_waitcnt lgkmcnt(0)" ::: "memory");
}

__device__ __forceinline__ void prologue(const Params& p, LAS unsigned char* lds) {
    unsigned char* ws_ = opq(p.ws);
    const int tid = opaque_tid(), lane = tid & 63, wave = tid >> 6;
    LAS float* cs = (LAS float*)lds;
    LAS float* red = (LAS float*)(lds + 40960);
    for (int i = tid; i < 5 * DM; i += 512) { const float v = (i < 4 * DM) ? opq(p.c)[i] : opq(p.c_ctx)[i - 4 * DM]; cs[i] = v / (1.0f + expf(-v)); }
    __syncthreads();
    float* modv = (float*)(ws_ + WS_MODV);
    for (int item = blockIdx.x; item < 384; item += gridDim.x) {
        const int l = item / 96, cgp = item - l * 96;
        const float* W = opq(p.mod_w) + (size_t)l * DM * 6144 + cgp * 64 + lane;
        float a0 = 0.f, a1 = 0.f, a2 = 0.f, a3 = 0.f, a4 = 0.f;
        const int k0 = wave * 256;
#pragma unroll 8
        for (int k = k0; k < k0 + 256; ++k) { const float w = __builtin_nontemporal_load(W + (size_t)k * 6144); a0 += cs[k] * w; a1 += cs[DM + k] * w; a2 += cs[2 * DM + k] * w; a3 += cs[3 * DM + k] * w; a4 += cs[4 * DM + k] * w; }
        red[(wave * 5 + 0) * 64 + lane] = a0; red[(wave * 5 + 1) * 64 + lane] = a1; red[(wave * 5 + 2) * 64 + lane] = a2; red[(wave * 5 + 3) * 64 + lane] = a3; red[(wave * 5 + 4) * 64 + lane] = a4;
        __syncthreads();
        if (tid < 320) { const int r = tid >> 6; float s = 0.f;
#pragma unroll
            for (int w = 0; w < 8; ++w) s += red[(w * 5 + r) * 64 + lane];
            modv[(size_t)(l * 5 + r) * 6144 + cgp * 64 + lane] = s + opq(p.mod_b)[l * 6144 + cgp * 64 + lane]; }
        __syncthreads();
    }
    {
        const int gt = blockIdx.x * 512 + tid;
        if (gt < 4096) { const int pos = gt >> 6, f = gt & 63; const float freq = exp2f(-(float)f * (13.287712379549449f / 64.0f)); const float ang = (float)pos * freq;
            float sn, cn; sincosf(ang, &sn, &cn); ((f32x2*)(ws_ + WS_ROPE))[gt] = (f32x2){cn, sn}; }
    }
    __syncthreads();
    LAS float* scr = (LAS float*)(lds + wave * 16640);
    const int gw = blockIdx.x * 8 + wave, NGW = gridDim.x * 8;
    constexpr int I_RI = 32 * 192, I_NI = 32 * 256, I_O = 64 * 32;
    constexpr int NITEMS = 2 * I_RI + 2 * I_NI + 4 * I_O;
    for (int it = gw; it < NITEMS; it += NGW) {
        int r = it;
        if (r < I_RI) { transpose_item(opq(p.ret_w_in), DM, NP_RET, (bf16_t*)(ws_ + WS_WRI0), scr, r, lane); continue; } r -= I_RI;
        if (r < I_O) { transpose_item(opq(p.ret_w_out), EB, DM, (bf16_t*)(ws_ + WS_WRO0), scr, r, lane); continue; } r -= I_O;
        if (r < I_NI) { transpose_item(opq(p.na_w_in), DM, NP_NA, (bf16_t*)(ws_ + WS_WNI0), scr, r, lane); continue; } r -= I_NI;
        if (r < I_O) { transpose_item(opq(p.na_w_out), EB, DM, (bf16_t*)(ws_ + WS_WNO0), scr, r, lane); continue; } r -= I_O;
        if (r < I_RI) { transpose_item(opq(p.ret_w_in) + (size_t)DM * NP_RET, DM, NP_RET, (bf16_t*)(ws_ + WS_WRI1), scr, r, lane); continue; } r -= I_RI;
        if (r < I_O) { transpose_item(opq(p.ret_w_out) + (size_t)EB * DM, EB, DM, (bf16_t*)(ws_ + WS_WRO1), scr, r, lane); continue; } r -= I_O;
        if (r < I_NI) { transpose_item(opq(p.na_w_in) + (size_t)DM * NP_NA, DM, NP_NA, (bf16_t*)(ws_ + WS_WNI1), scr, r, lane); continue; } r -= I_NI;
        transpose_item(opq(p.na_w_out) + (size_t)EB * DM, EB, DM, (bf16_t*)(ws_ + WS_WNO1), scr, r, lane);
    }
    __syncthreads();
}

__device__ __forceinline__ void norm_emit(const f32x4 (&v)[8], const f32x4 (&gs)[8], const f32x4 (&sh)[8], bf16_t* hrow, int lane) {
    float ss = 0.f;
#pragma unroll
    for (int j = 0; j < 8; ++j) ss += (v[j][0] * v[j][0] + v[j][1] * v[j][1]) + (v[j][2] * v[j][2] + v[j][3] * v[j][3]);
    ss = wave_sum(ss);
    const float rstd = 1.0f / sqrtf(ss * (1.0f / DM) + EPS);
    u32x2* o = (u32x2*)hrow;
#pragma unroll
    for (int j = 0; j < 8; ++j) { const f32x4 hv = v[j] * rstd * gs[j] + sh[j];
        u32x2 w; w.x = cvt_pk_bf16(hv[0], hv[1]); w.y = cvt_pk_bf16(hv[2], hv[3]); o[lane + 64 * j] = w; }
}
__device__ __forceinline__ void norm_phase(const Params& p, int l) {
    unsigned char* ws_ = opq(p.ws);
    const int tid = opaque_tid(), lane = tid & 63, wave = tid >> 6;
    const int gw = blockIdx.x * 8 + wave, NGW = gridDim.x * 8;
    float* XS = (float*)(ws_ + WS_XS);
    const float* modv = (const float*)(ws_ + WS_MODV);
    const float* PART = (const float*)(ws_ + WS_PART);
    bf16_t* H = (bf16_t*)(ws_ + WS_H);
    const f32x4* g4 = (const f32x4*)(opq(p.norm_g) + l * DM);
    f32x4 gg[8];
#pragma unroll
    for (int j = 0; j < 8; ++j) gg[j] = g4[lane + 64 * j];
    for (int m = ML + gw; m < MT; m += NGW) {
        const float* src = (l <= 1) ? opq(p.ctx) + (size_t)(m - ML) * DM : XS + (size_t)m * DM;
        const f32x4* sh4 = (const f32x4*)(modv + (size_t)(l * 5 + 4) * 6144);
        f32x4 v[8], gs[8], sh[8];
#pragma unroll
        for (int j = 0; j < 8; ++j) { v[j] = ((const f32x4*)src)[lane + 64 * j]; gs[j] = gg[j] * (sh4[DM / 4 + lane + 64 * j] + 1.0f); sh[j] = sh4[lane + 64 * j]; }
        if (l != 0) {
            const f32x4* gt4 = (const f32x4*)(modv + (size_t)((l - 1) * 5 + 4) * 6144 + 4096);
            const f32x4* pp = (const f32x4*)(PART + (size_t)(m - ML) * DM);
#pragma unroll
            for (int j = 0; j < 8; ++j) { f32x4 a = (f32x4){0.f, 0.f, 0.f, 0.f};
#pragma unroll
                for (int sp = 0; sp < 8; ++sp) a += pp[(size_t)sp * (MC * DM / 4) + lane + 64 * j];
                v[j] += gt4[lane + 64 * j] * a; }
#pragma unroll
            for (int j = 0; j < 8; ++j) ((f32x4*)(XS + (size_t)m * DM))[lane + 64 * j] = v[j];
        }
        norm_emit(v, gs, sh, H + (size_t)m * DM, lane);
    }
    const float* lsrc = (l == 0) ? opq(p.x) : (const float*)XS;
    int pstart = gw, pend = ML / 2, pstep = NGW;
    if (l > 0 && NGW == 2048) { if (gw < 1024) { pstart = gw; pend = gw + 1; } else { pstart = 1024 + (gw - 1024) * 3; pend = pstart + 3; } pstep = 1; }
    for (int pi = pstart; pi < pend; pi += pstep) {
        const int m0 = pi * 2;
        const f32x4* sh4 = (const f32x4*)(modv + (size_t)(l * 5 + (m0 >> 11)) * 6144);
        f32x4 va[8], vb[8], gs[8], sh[8];
#pragma unroll
        for (int j = 0; j < 8; ++j) { va[j] = ((const f32x4*)(lsrc + (size_t)m0 * DM))[lane + 64 * j]; vb[j] = ((const f32x4*)(lsrc + (size_t)(m0 + 1) * DM))[lane + 64 * j];
            gs[j] = gg[j] * (sh4[DM / 4 + lane + 64 * j] + 1.0f); sh[j] = sh4[lane + 64 * j]; }
        norm_emit(va, gs, sh, H + (size_t)m0 * DM, lane);
        norm_emit(vb, gs, sh, H + (size_t)(m0 + 1) * DM, lane);
    }
}
__device__ __forceinline__ void final_norm(const Params& p) {
    unsigned char* ws_ = opq(p.ws);
    const int tid = opaque_tid(), lane = tid & 63, wave = tid >> 6;
    const int gw = blockIdx.x * 8 + wave, NGW = gridDim.x * 8;
    const float* XS = (const float*)(ws_ + WS_XS);
    const f32x4* g4 = (const f32x4*)opq(p.final_g);
    float* outp = opq(p.out);
    f32x4 gg[8];
#pragma unroll
    for (int j = 0; j < 8; ++j) gg[j] = g4[lane + 64 * j];
    for (int m0 = gw * 2; m0 < ML; m0 += NGW * 2) {
        f32x4 v[2][8];
#pragma unroll
        for (int q = 0; q < 2; ++q)
#pragma unroll
            for (int j = 0; j < 8; ++j) v[q][j] = ((const f32x4*)(XS + (size_t)(m0 + q) * DM))[lane + 64 * j];
#pragma unroll
        for (int q = 0; q < 2; ++q) { float ss = 0.f;
#pragma unroll
            for (int j = 0; j < 8; ++j) ss += (v[q][j][0] * v[q][j][0] + v[q][j][1] * v[q][j][1]) + (v[q][j][2] * v[q][j][2] + v[q][j][3] * v[q][j][3]);
            ss = wave_sum(ss);
            const float rstd = 1.0f / sqrtf(ss * (1.0f / DM) + EPS);
            f32x4* o = (f32x4*)(outp + (size_t)(m0 + q) * DM);
#pragma unroll
            for (int j = 0; j < 8; ++j) o[lane + 64 * j] = v[q][j] * rstd * gg[j];
        }
    }
}

constexpr int RQ_STRIDE = 528, RK_STRIDE = 544, RV_STRIDE = 288, RP_STRIDE = 144;
constexpr int R_QS = 0, R_KS = 33792, R_VS = 68608, R_PS = 87040;
__device__ __forceinline__ void ret_phaseA(const Params& p, int j, LAS unsigned char* lds) {
    unsigned char* ws_ = opq(p.ws);
    const int tid = opaque_tid(), lane = tid & 63, w = __builtin_amdgcn_readfirstlane(tid >> 6), g = lane >> 4, li = lane & 15;
    const int tq = li >> 2, tp = li & 3;
    const bf16_t* PROJ = (const bf16_t*)(ws_ + WS_PROJ);
    bf16_t* OFB = (bf16_t*)(ws_ + WS_OFB);
    const f32x2* rope = (const f32x2*)(ws_ + WS_ROPE);
    LAS unsigned char* Qs = lds + R_QS; LAS unsigned char* Ks = lds + R_KS; LAS unsigned char* Vs = lds + R_VS; LAS unsigned char* Ps = lds + R_PS;
    for (int u = blockIdx.x; u < 256; u += gridDim.x) {
        const int slice = (u >> 3) & 3, grp = (u & 7) | ((u >> 5) << 3), dir = grp & 1, h = (grp >> 1) & 7, b = grp >> 4;
        const float raw = (dir ? opq(p.ret_db) : opq(p.ret_df))[j * 8 + h];
        const float lg = -log1pf(expf(raw));
        const float cdec = expf(lg * 64.0f);
        f32x4 S[16];
#pragma unroll
        for (int i = 0; i < 16; ++i) S[i] = (f32x4){0.f, 0.f, 0.f, 0.f};
        u32x4 pq[2][2], pk[2][2], pv[2];
#define RET_ROWBASE(s, rb, cc, isctx) do { isctx = (s) < 4; const int ci_ = isctx ? (s) : (s) - 4; const int nch_ = isctx ? 4 : 32; cc = dir ? nch_ - 1 - ci_ : ci_; \
        rb = isctx ? ML + b * CTXL + cc * 64 : b * SEQ + cc * 64; } while (0)
#define RET_LOAD(s) do { int rb_, cc_; bool ic_; RET_ROWBASE(s, rb_, cc_, ic_); _Pragma("unroll") for (int t = 0; t < 2; ++t) { const int tk = tid + 512 * t; const int row = tk >> 4, sub = tk & 15; \
        const int d0 = (sub >> 3) * 128 + (sub & 7) * 8; const bf16_t* sp = PROJ + (size_t)(rb_ + row) * NP_RET + h * 256 + d0; \
        pq[t][0] = *(const u32x4*)sp; pq[t][1] = *(const u32x4*)(sp + 64); pk[t][0] = *(const u32x4*)(sp + 2048); pk[t][1] = *(const u32x4*)(sp + 2048 + 64); \
        pv[t] = *(const u32x4*)(PROJ + (size_t)(rb_ + row) * NP_RET + 4096 + h * 512 + slice * 128 + sub * 8); } } while (0)
        RET_LOAD(0);
        for (int s = 0; s < 36; ++s) {
            int rowbase, cc; bool isctx; RET_ROWBASE(s, rowbase, cc, isctx);
#pragma unroll
            for (int t = 0; t < 2; ++t) {
                const int tk = tid + 512 * t; const int row = tk >> 4, sub = tk & 15; const int half = sub >> 3, gq = sub & 7; const int d0 = half * 128 + gq * 8;
                const float e_i = dir ? (float)(64 - row) : (float)(row + 1);
                const float fqs = expf(lg * e_i), fks = expf(-lg * e_i) * 0.0625f;
                float q1[8], q2[8], k1[8], k2[8];
#pragma unroll
                for (int e = 0; e < 4; ++e) { q1[2 * e] = bf_lo(pq[t][0][e]); q1[2 * e + 1] = bf_hi(pq[t][0][e]); q2[2 * e] = bf_lo(pq[t][1][e]); q2[2 * e + 1] = bf_hi(pq[t][1][e]);
                    k1[2 * e] = bf_lo(pk[t][0][e]); k1[2 * e + 1] = bf_hi(pk[t][0][e]); k2[2 * e] = bf_lo(pk[t][1][e]); k2[2 * e + 1] = bf_hi(pk[t][1][e]); }
                if (!isctx) {
                    const int pos = half ? row : cc;
                    const f32x4* rp = (const f32x4*)(rope + pos * 64 + gq * 8);
#pragma unroll
                    for (int e = 0; e < 4; ++e) { const f32x4 cs2 = rp[e];
                        { const float c0 = cs2[0], s0 = cs2[1]; const float a = q1[2 * e], bb = q2[2 * e]; q1[2 * e] = a * c0 - bb * s0; q2[2 * e] = a * s0 + bb * c0;
                          const float ka = k1[2 * e], kb = k2[2 * e]; k1[2 * e] = ka * c0 - kb * s0; k2[2 * e] = ka * s0 + kb * c0; }
                        { const float c0 = cs2[2], s0 = cs2[3]; const float a = q1[2 * e + 1], bb = q2[2 * e + 1]; q1[2 * e + 1] = a * c0 - bb * s0; q2[2 * e + 1] = a * s0 + bb * c0;
                          const float ka = k1[2 * e + 1], kb = k2[2 * e + 1]; k1[2 * e + 1] = ka * c0 - kb * s0; k2[2 * e + 1] = ka * s0 + kb * c0; } }
                }
                u32x4 o;
                o.x = cvt_pk_bf16(q1[0] * fqs, q1[1] * fqs); o.y = cvt_pk_bf16(q1[2] * fqs, q1[3] * fqs); o.z = cvt_pk_bf16(q1[4] * fqs, q1[5] * fqs); o.w = cvt_pk_bf16(q1[6] * fqs, q1[7] * fqs);
                *(LAS u32x4*)(Qs + row * RQ_STRIDE + d0 * 2) = o;
                o.x = cvt_pk_bf16(q2[0] * fqs, q2[1] * fqs); o.y = cvt_pk_bf16(q2[2] * fqs, q2[3] * fqs); o.z = cvt_pk_bf16(q2[4] * fqs, q2[5] * fqs); o.w = cvt_pk_bf16(q2[6] * fqs, q2[7] * fqs);
                *(LAS u32x4*)(Qs + row * RQ_STRIDE + (d0 + 64) * 2) = o;
                o.x = cvt_pk_bf16(k1[0] * fks, k1[1] * fks); o.y = cvt_pk_bf16(k1[2] * fks, k1[3] * fks); o.z = cvt_pk_bf16(k1[4] * fks, k1[5] * fks); o.w = cvt_pk_bf16(k1[6] * fks, k1[7] * fks);
                *(LAS u32x4*)(Ks + row * RK_STRIDE + d0 * 2) = o;
                o.x = cvt_pk_bf16(k2[0] * fks, k2[1] * fks); o.y = cvt_pk_bf16(k2[2] * fks, k2[3] * fks); o.z = cvt_pk_bf16(k2[4] * fks, k2[5] * fks); o.w = cvt_pk_bf16(k2[6] * fks, k2[7] * fks);
                *(LAS u32x4*)(Ks + row * RK_STRIDE + (d0 + 64) * 2) = o;
                *(LAS u32x4*)(Vs + row * RV_STRIDE + sub * 16) = pv[t];
            }
            __syncthreads();
            if (s + 1 < 36) RET_LOAD(s + 1);
            {
                const int ib = w >> 1;
#pragma unroll
                for (int t = 0; t < 2; ++t) {
                    const int jb = 2 * (w & 1) + t;
                    f32x4 acc = (f32x4){0.f, 0.f, 0.f, 0.f};
                    const bool nz = dir ? (jb >= ib) : (jb <= ib);
                    if (nz) {
                        const LAS unsigned char* kp_ = Ks + (jb * 16 + li) * RK_STRIDE + (8 * g) * 2; const LAS unsigned char* qp_ = Qs + (ib * 16 + li) * RQ_STRIDE + (8 * g) * 2;
                        bf16x8 na_ = *(const LAS bf16x8*)kp_, nb_ = *(const LAS bf16x8*)qp_, na2_ = *(const LAS bf16x8*)(kp_ + 64), nb2_ = *(const LAS bf16x8*)(qp_ + 64);
#pragma unroll
                        for (int kk = 0; kk < 8; ++kk) {
                            const bf16x8 a = na_, bq = nb_; na_ = na2_; nb_ = nb2_;
                            if (kk + 2 < 8) { na2_ = *(const LAS bf16x8*)(kp_ + (kk + 2) * 64); nb2_ = *(const LAS bf16x8*)(qp_ + (kk + 2) * 64); }
                            acc = __builtin_amdgcn_mfma_f32_16x16x32_bf16(a, bq, acc, 0, 0, 0);
                            __builtin_amdgcn_sched_barrier(0);
                        }
                        const int i = ib * 16 + li;
#pragma unroll
                        for (int r = 0; r < 4; ++r) { const int jj = jb * 16 + 4 * g + r; const bool keep = dir ? (jj >= i) : (jj <= i); acc[r] = keep ? acc[r] : 0.f; }
                    }
                    u32x2 wv; wv.x = cvt_pk_bf16(acc[0], acc[1]); wv.y = cvt_pk_bf16(acc[2], acc[3]);
                    *(LAS u32x2*)(Ps + (ib * 16 + li) * RP_STRIDE + (jb * 16 + 4 * g) * 2) = wv;
                }
            }
            f32x4 oacc[4];
#pragma unroll
            for (int ib = 0; ib < 4; ++ib) oacc[ib] = (f32x4){0.f, 0.f, 0.f, 0.f};
            {
                const LAS unsigned char* qa0 = Qs + li * RQ_STRIDE + (4 * g) * 2;
#define RET_QF(idx) cat8(*(const LAS s16x4*)(qa0 + ((idx) & 3) * 16 * RQ_STRIDE + ((idx) >> 2) * 64), *(const LAS s16x4*)(qa0 + ((idx) & 3) * 16 * RQ_STRIDE + ((idx) >> 2) * 64 + 32))
                bf16x8 qn0 = RET_QF(0), qn1 = RET_QF(1), qn2 = RET_QF(2);
#pragma unroll
                for (int T = 0; T < 8; ++T) {
                    const bf16x8 bfrag = pack8(S[2 * T], S[2 * T + 1]);
#pragma unroll
                    for (int ib = 0; ib < 4; ++ib) {
                        const int idx = T * 4 + ib; const bf16x8 a = qn0; qn0 = qn1; qn1 = qn2;
                        if (idx + 3 < 32) qn2 = RET_QF(idx + 3);
                        oacc[ib] = __builtin_amdgcn_mfma_f32_16x16x32_bf16(a, bfrag, oacc[ib], 0, 0, 0);
                        __builtin_amdgcn_sched_barrier(0);
                    }
                }
#undef RET_QF
            }
            bf16x8 vfrag[2];
#pragma unroll
            for (int ks = 0; ks < 2; ++ks) {
                LAS unsigned char* va = Vs + (32 * ks + 4 * g + tq) * RV_STRIDE + (w * 16 + 4 * tp) * 2;
                vfrag[ks] = cat8(tr_read(va), tr_read(va + 16 * RV_STRIDE));
            }
            {
                LAS unsigned char* ka0 = Ks + (4 * g + tq) * RK_STRIDE + (4 * tp) * 2;
#define RET_KF(idx) cat8(tr_read(ka0 + ((idx) & 1) * 32 * RK_STRIDE + ((idx) >> 1) * 32), tr_read(ka0 + ((idx) & 1) * 32 * RK_STRIDE + ((idx) >> 1) * 32 + 16 * RK_STRIDE))
                bf16x8 kn0 = RET_KF(0), kn1 = RET_KF(1), kn2 = RET_KF(2);
#pragma unroll
                for (int dkb = 0; dkb < 16; ++dkb) {
#pragma unroll
                    for (int ks = 0; ks < 2; ++ks) {
                        const int idx = dkb * 2 + ks; const bf16x8 a = kn0; kn0 = kn1; kn1 = kn2;
                        if (idx + 3 < 32) kn2 = RET_KF(idx + 3);
                        S[dkb] = __builtin_amdgcn_mfma_f32_16x16x32_bf16(a, vfrag[ks], S[dkb], 0, 0, 0);
                        __builtin_amdgcn_sched_barrier(0);
                    }
                    S[dkb] = S[dkb] * cdec;
                }
#undef RET_KF
            }
            __syncthreads();
#pragma unroll
            for (int ib = 0; ib < 4; ++ib)
#pragma unroll
                for (int ks = 0; ks < 2; ++ks) {
                    const LAS unsigned char* pa = Ps + (ib * 16 + li) * RP_STRIDE + (32 * ks + 4 * g) * 2;
                    const bf16x8 a = cat8(*(const LAS s16x4*)pa, *(const LAS s16x4*)(pa + 32));
                    oacc[ib] = __builtin_amdgcn_mfma_f32_16x16x32_bf16(a, vfrag[ks], oacc[ib], 0, 0, 0);
                }
            {
                bf16_t* ob = OFB + ((size_t)dir * MT + rowbase) * EB + h * 512 + slice * 128 + w * 16 + li;
#pragma unroll
                for (int ib = 0; ib < 4; ++ib)
#pragma unroll
                    for (int r = 0; r < 4; ++r) { const unsigned pk2 = cvt_pk_bf16(oacc[ib][r], 0.f); ob[(size_t)(ib * 16 + 4 * g + r) * EB] = (bf16_t)(pk2 & 0xffffu); }
            }
        }
#undef RET_LOAD
#undef RET_ROWBASE
    }
}
__device__ __forceinline__ void ret_phaseB(const Params& p) {
    unsigned char* ws_ = opq(p.ws);
    const int tid = opaque_tid(), lane = tid & 63, wave = tid >> 6;
    const int gw = blockIdx.x * 8 + wave, NGW = gridDim.x * 8;
    const bf16_t* PROJ = (const bf16_t*)(ws_ + WS_PROJ);
    const bf16_t* OFB = (const bf16_t*)(ws_ + WS_OFB);
    bf16_t* GATED = (bf16_t*)(ws_ + WS_GATED);
    for (int it0 = gw * 4; it0 < MT * 8; it0 += NGW * 4) {
        u32x4 of[4], ob[4], gg[4];
#pragma unroll
        for (int q = 0; q < 4; ++q) { const int item = it0 + q; const int m = item >> 3, h = item & 7; const size_t off = (size_t)m * EB + h * 512 + lane * 8;
            of[q] = *(const u32x4*)(OFB + off); ob[q] = *(const u32x4*)(OFB + (size_t)MT * EB + off); gg[q] = *(const u32x4*)(PROJ + (size_t)m * NP_RET + 8192 + h * 512 + lane * 8); }
#pragma unroll
        for (int q = 0; q < 4; ++q) { const int item = it0 + q; const int m = item >> 3, h = item & 7; const size_t off = (size_t)m * EB + h * 512 + lane * 8;
            float o[8]; float ss = 0.f;
#pragma unroll
            for (int e = 0; e < 4; ++e) { o[2 * e] = bf_lo(of[q][e]) + bf_lo(ob[q][e]); o[2 * e + 1] = bf_hi(of[q][e]) + bf_hi(ob[q][e]); ss += o[2 * e] * o[2 * e] + o[2 * e + 1] * o[2 * e + 1]; }
            ss = wave_sum(ss);
            const float rn = 1.0f / sqrtf(ss * (1.0f / 512.0f) + EPS);
            u32x4 r;
#pragma unroll
            for (int e = 0; e < 4; ++e) { const float g0 = bf_lo(gg[q][e]), g1 = bf_hi(gg[q][e]); r[e] = cvt_pk_bf16(silu_f(g0) * o[2 * e] * rn, silu_f(g1) * o[2 * e + 1] * rn); }
            *(u32x4*)(GATED + off) = r; }
    }
}

constexpr int NA_KSTR = 272, NA_VSTR = 288, NA_VOFF = 17408, NA_BUF = 35840, NA_RPB = 71680, NA_QOFF = 73728, NA_QW = 8704;
constexpr float LOG2E = 1.4426950408889634f;
struct NaQ { f32x4 o[8]; float m, l, pend; };
__device__ __forceinline__ bf16x8 na_softmax(const f32x4 s0, const f32x4 s1, NaQ& q, const bool first) {
    const float x = fmaxf(fmaxf(fmaxf(s0[0], s0[1]), fmaxf(s0[2], s0[3])), fmaxf(fmaxf(s1[0], s1[1]), fmaxf(s1[2], s1[3])));
    const float xa = __shfl_xor(x, 16), xb = __shfl_xor(x, 32), xc = __shfl_xor(x, 48);
    if (first) { const float tmax = fmaxf(fmaxf(x, xa), fmaxf(xb, xc)); q.m = tmax; q.pend = tmax; }
    else {
        const bool need = q.pend > q.m + 8.0f;
        if (__builtin_amdgcn_ballot_w64(need) != 0ull) {
            const float mnew = need ? q.pend : q.m; const float alpha = __builtin_amdgcn_exp2f(q.m - mnew);
#pragma unroll
            for (int db = 0; db < 8; ++db) q.o[db] = q.o[db] * alpha;
            q.l *= alpha; q.m = mnew;
        }
    }
    f32x4 p0, p1;
#pragma unroll
    for (int rr = 0; rr < 4; ++rr) { p0[rr] = __builtin_amdgcn_exp2f(s0[rr] - q.m); p1[rr] = __builtin_amdgcn_exp2f(s1[rr] - q.m); }
    q.l += ((p0[0] + p0[1]) + (p0[2] + p0[3])) + ((p1[0] + p1[1]) + (p1[2] + p1[3]));
    const bf16x8 pf = pack8(p0, p1);
    if (!first) q.pend = fmaxf(q.pend, fmaxf(fmaxf(x, xa), fmaxf(xb, xc)));
    return pf;
}
__device__ __forceinline__ void na_group2(const bool f0, const bool f1, const LAS unsigned char* Qw, LAS unsigned char* Kb, LAS unsigned char* Vb, int cb, bool local, int rb0, const LAS float* rpbs, float sc2,
                                          unsigned vmask, int cbase, NaQ& q0, NaQ& q1, int li, int g, int tq, int tp) {
    f32x4 s00 = (f32x4){0.f, 0.f, 0.f, 0.f}, s01 = s00, s10 = s00, s11 = s00;
#pragma unroll
    for (int kk = 0; kk < 4; ++kk) {
        const bf16x8 ka = *(const LAS bf16x8*)(Kb + (cb + li) * NA_KSTR + (kk * 32 + 8 * g) * 2);
        const bf16x8 kb = *(const LAS bf16x8*)(Kb + (cb + 16 + li) * NA_KSTR + (kk * 32 + 8 * g) * 2);
        const bf16x8 qa = *(const LAS bf16x8*)(Qw + li * NA_KSTR + (kk * 32 + 8 * g) * 2);
        const bf16x8 qb2 = *(const LAS bf16x8*)(Qw + (16 + li) * NA_KSTR + (kk * 32 + 8 * g) * 2);
        s00 = __builtin_amdgcn_mfma_f32_16x16x32_bf16(ka, qa, s00, 0, 0, 0); s01 = __builtin_amdgcn_mfma_f32_16x16x32_bf16(kb, qa, s01, 0, 0, 0);
        s10 = __builtin_amdgcn_mfma_f32_16x16x32_bf16(ka, qb2, s10, 0, 0, 0); s11 = __builtin_amdgcn_mfma_f32_16x16x32_bf16(kb, qb2, s11, 0, 0, 0);
    }
    s00 = s00 * sc2; s01 = s01 * sc2; s10 = s10 * sc2; s11 = s11 * sc2;
    if (local) { const int rb1 = rb0 - 31;
#pragma unroll
        for (int k = 0; k < 4; ++k) { const bool v0 = (vmask >> k) & 1u, v1 = (vmask >> (k + 4)) & 1u;
            const int c0 = min(max(cbase + k, 0), 30), c1 = min(max(cbase + 16 + k, 0), 30);
            float b00 = rpbs[rb0 + c0], b01 = rpbs[rb0 + c1], b10 = rpbs[rb1 + c0], b11 = rpbs[rb1 + c1];
            asm volatile("" : "+v"(b00), "+v"(b01), "+v"(b10), "+v"(b11));
            s00[k] = v0 ? s00[k] + b00 : -INFINITY; s01[k] = v1 ? s01[k] + b01 : -INFINITY;
            s10[k] = v0 ? s10[k] + b10 : -INFINITY; s11[k] = v1 ? s11[k] + b11 : -INFINITY; } }
    const bf16x8 pf0 = na_softmax(s00, s01, q0, f0);
    const bf16x8 pf1 = na_softmax(s10, s11, q1, f1);
    LAS unsigned char* va0 = Vb + (cb + 4 * g + tq) * NA_VSTR + (4 * tp) * 2;
    bf16x8 an0 = cat8(tr_read(va0), tr_read(va0 + 16 * NA_VSTR));
    bf16x8 an1 = cat8(tr_read(va0 + 32), tr_read(va0 + 32 + 16 * NA_VSTR));
    bf16x8 an2 = cat8(tr_read(va0 + 64), tr_read(va0 + 64 + 16 * NA_VSTR));
#pragma unroll
    for (int db = 0; db < 8; ++db) {
        const bf16x8 a = an0; an0 = an1; an1 = an2;
        if (db + 3 < 8) { LAS unsigned char* va = va0 + (db + 3) * 32; an2 = cat8(tr_read(va), tr_read(va + 16 * NA_VSTR)); }
        q0.o[db] = __builtin_amdgcn_mfma_f32_16x16x32_bf16(a, pf0, q0.o[db], 0, 0, 0);
        q1.o[db] = __builtin_amdgcn_mfma_f32_16x16x32_bf16(a, pf1, q1.o[db], 0, 0, 0);
        __builtin_amdgcn_sched_barrier(0);
    }
}
__device__ __forceinline__ void na_group1(const bool f, const LAS unsigned char* Qw, LAS unsigned char* Kb, LAS unsigned char* Vb, int cb, int rb, const LAS float* rpbs, float sc2,
                                          unsigned vmask, int cbase, NaQ& q, int li, int g, int tq, int tp) {
    f32x4 s0 = (f32x4){0.f, 0.f, 0.f, 0.f}, s1 = s0;
#pragma unroll
    for (int kk = 0; kk < 4; ++kk) {
        const bf16x8 ka = *(const LAS bf16x8*)(Kb + (cb + li) * NA_KSTR + (kk * 32 + 8 * g) * 2);
        const bf16x8 kb = *(const LAS bf16x8*)(Kb + (cb + 16 + li) * NA_KSTR + (kk * 32 + 8 * g) * 2);
        const bf16x8 qa = *(const LAS bf16x8*)(Qw + li * NA_KSTR + (kk * 32 + 8 * g) * 2);
        s0 = __builtin_amdgcn_mfma_f32_16x16x32_bf16(ka, qa, s0, 0, 0, 0); s1 = __builtin_amdgcn_mfma_f32_16x16x32_bf16(kb, qa, s1, 0, 0, 0);
    }
    s0 = s0 * sc2; s1 = s1 * sc2;
#pragma unroll
    for (int k = 0; k < 4; ++k) { const bool v0 = (vmask >> k) & 1u, v1 = (vmask >> (k + 4)) & 1u;
        const int c0 = min(max(cbase + k, 0), 30), c1 = min(max(cbase + 16 + k, 0), 30);
        float b0 = rpbs[rb + c0], b1 = rpbs[rb + c1]; asm volatile("" : "+v"(b0), "+v"(b1));
        s0[k] = v0 ? s0[k] + b0 : -INFINITY; s1[k] = v1 ? s1[k] + b1 : -INFINITY; }
    const bf16x8 pf = na_softmax(s0, s1, q, f);
    LAS unsigned char* va0 = Vb + (cb + 4 * g + tq) * NA_VSTR + (4 * tp) * 2;
    bf16x8 an0 = cat8(tr_read(va0), tr_read(va0 + 16 * NA_VSTR));
    bf16x8 an1 = cat8(tr_read(va0 + 32), tr_read(va0 + 32 + 16 * NA_VSTR));
#pragma unroll
    for (int db = 0; db < 8; ++db) {
        const bf16x8 a = an0; an0 = an1;
        if (db + 2 < 8) { LAS unsigned char* va = va0 + (db + 2) * 32; an1 = cat8(tr_read(va), tr_read(va + 16 * NA_VSTR)); }
        q.o[db] = __builtin_amdgcn_mfma_f32_16x16x32_bf16(a, pf, q.o[db], 0, 0, 0);
        __builtin_amdgcn_sched_barrier(0);
    }
}
__device__ __forceinline__ void na_phase(const Params& p, int j, bool with_ctx, LAS unsigned char* lds) {
    unsigned char* ws_ = opq(p.ws);
    const int tid = opaque_tid(), lane = tid & 63, w = __builtin_amdgcn_readfirstlane(tid >> 6), g = lane >> 4, li = lane & 15;
    const int tq = li >> 2, tp = li & 3;
    const bf16_t* PROJ = (const bf16_t*)(ws_ + WS_PROJ);
    bf16_t* GATED = (bf16_t*)(ws_ + WS_GATED);
    LAS float* rpbs = (LAS float*)(lds + NA_RPB);
    const float sc2 = 0.08838834764831845f * LOG2E;
    const int NU = 1024 + (with_ctx ? 128 : 0);
    for (int u = blockIdx.x; u < NU; u += gridDim.x) {
        const bool isctx = u >= 1024;
        int b, head, qb = 0, r0 = 0, rs0 = 0, nloc = 0, qrow0, qrow1, rsw0 = 0, rsw1 = 0;
        if (!isctx) {
            const int rnd = u / (int)gridDim.x, bx = u - rnd * (int)gridDim.x; const int grp = (gridDim.x == 256) ? rnd * 32 + (bx & 7) * 4 + (bx >> 6) : (u >> 3);
            const int rq = (gridDim.x == 256) ? ((bx >> 3) & 7) : (u & 7); b = grp >> 5; head = grp & 31; qb = w & 3; r0 = 4 * rq + 2 * (w >> 2);
            qrow0 = b * SEQ + r0 * 64 + qb * 16; qrow1 = qrow0 + 64; rsw0 = min(max(r0 - 4, 0), 24); rsw1 = min(max(r0 - 3, 0), 24);
            rs0 = min(max(4 * rq - 4, 0), 24); nloc = min(max(4 * rq - 1, 0), 24) + 8 - rs0; }
        else { const int v = u - 1024; b = v >> 5; head = v & 31; qrow0 = ML + b * CTXL + w * 16; qrow1 = qrow0 + 128; }
        const int nit = nloc + 4;
        const int cb_loc = (qb == 0) ? 0 : (qb == 1) ? 8 : (qb == 2) ? 24 : 32;
        if (tid < 465) rpbs[tid] = opq(p.na_rpb)[(size_t)(j * 32 + head) * 465 + tid] * LOG2E;
        unsigned vmask = 0; const int cbase = cb_loc + 4 * g - (qb * 16 + li) + 15;
        { const int qc = qb * 16 + li; const int wsx = min(max(qc - 8, 0), 48);
#pragma unroll
          for (int k = 0; k < 8; ++k) { const int kc = cb_loc + (k >> 2) * 16 + 4 * g + (k & 3); vmask |= ((kc >= wsx) && (kc < wsx + 16)) ? (1u << k) : 0u; } }
        NaQ q0, q1;
        LAS unsigned char* Qw = lds + NA_QOFF + w * NA_QW;
#pragma unroll
        for (int db = 0; db < 8; ++db) { q0.o[db] = (f32x4){0.f, 0.f, 0.f, 0.f}; q1.o[db] = (f32x4){0.f, 0.f, 0.f, 0.f}; }
        q0.m = 0.f; q1.m = 0.f; q0.l = 0.f; q1.l = 0.f; q0.pend = 0.f; q1.pend = 0.f;
        u32x4 pA[2][2];
#define NA_LOAD(it, R) do { const int trow_ = ((it) < nloc) ? b * SEQ + (rs0 + (it)) * 64 : ML + b * CTXL + ((it) - nloc) * 64; _Pragma("unroll") for (int t = 0; t < 2; ++t) { const int idx = tid + 512 * t; \
        const bf16_t* sp = PROJ + (size_t)(trow_ + (idx >> 4)) * NP_NA + 4096 + head * 128 + (idx & 15) * 8; R[t][0] = *(const u32x4*)sp; R[t][1] = *(const u32x4*)(sp + 4096); } } while (0)
#define NA_STORE(buf, R) do { _Pragma("unroll") for (int t = 0; t < 2; ++t) { const int idx = tid + 512 * t; LAS unsigned char* dp = lds + (buf) * NA_BUF; \
        *(LAS u32x4*)(dp + (idx >> 4) * NA_KSTR + (idx & 15) * 16) = R[t][0]; *(LAS u32x4*)(dp + NA_VOFF + (idx >> 4) * NA_VSTR + (idx & 15) * 16) = R[t][1]; } } while (0)
        {
            u32x4 qv[8];
#pragma unroll
            for (int i = 0; i < 8; ++i) { const int c = lane + 64 * i, row = c >> 4, ch = c & 15;
                qv[i] = *(const u32x4*)(PROJ + (size_t)((row < 16 ? qrow0 : qrow1) + (row & 15)) * NP_NA + head * 128 + ch * 8); }
            NA_LOAD(0, pA);
#pragma unroll
            for (int i = 0; i < 8; ++i) { const int c = lane + 64 * i, row = c >> 4, ch = c & 15; *(LAS u32x4*)(Qw + row * NA_KSTR + ch * 16) = qv[i]; }
            NA_STORE(0, pA);
        }
        __syncthreads();
        for (int it = 0; it < nit; ++it) {
            const int cur = it & 1;
            if (it + 1 < nit) NA_LOAD(it + 1, pA);
            const bool local = it < nloc; const int kr = rs0 + it;
            LAS unsigned char* Kb = lds + cur * NA_BUF; LAS unsigned char* Vb = Kb + NA_VOFF;
            if (local) {
                const bool act0 = (kr >= rsw0 && kr < rsw0 + 8), act1 = (kr >= rsw1 && kr < rsw1 + 8); const int rb0 = (kr - r0 + 7) * 31;
                if (act0 && act1) na_group2(kr == rsw0, kr == rsw1, Qw, Kb, Vb, cb_loc, true, rb0, rpbs, sc2, vmask, cbase, q0, q1, li, g, tq, tp);
                else if (act0) na_group1(kr == rsw0, Qw, Kb, Vb, cb_loc, rb0, rpbs, sc2, vmask, cbase, q0, li, g, tq, tp);
                else if (act1) na_group1(kr == rsw1, Qw + 16 * NA_KSTR, Kb, Vb, cb_loc, rb0 - 31, rpbs, sc2, vmask, cbase, q1, li, g, tq, tp);
            } else {
                const bool f_ = isctx && it == 0;
                for (int gi = 0; gi < 2; ++gi) na_group2(f_ && gi == 0, f_ && gi == 0, Qw, Kb, Vb, gi * 32, false, 0, rpbs, sc2, vmask, cbase, q0, q1, li, g, tq, tp);
            }
            if (it + 1 < nit) NA_STORE(cur ^ 1, pA);
            __syncthreads();
        }
#undef NA_LOAD
#undef NA_STORE
#pragma unroll
        for (int t = 0; t < 2; ++t) {
            float lt = t ? q1.l : q0.l; lt += __shfl_xor(lt, 16); lt += __shfl_xor(lt, 32);
            const float inv = 1.0f / lt; const size_t row = (size_t)((t ? qrow1 : qrow0) + li);
#pragma unroll
            for (int db = 0; db < 8; ++db) { const int d = db * 16 + 4 * g; const f32x4 ov = t ? q1.o[db] : q0.o[db];
                const u32x2 gg = *(const u32x2*)(PROJ + row * NP_NA + 12288 + head * 128 + d);
                u32x2 wv; wv.x = cvt_pk_bf16(ov[0] * inv * silu_f(bf_lo(gg.x)), ov[1] * inv * silu_f(bf_hi(gg.x)));
                wv.y = cvt_pk_bf16(ov[2] * inv * silu_f(bf_lo(gg.y)), ov[3] * inv * silu_f(bf_hi(gg.y)));
                *(u32x2*)(GATED + row * EB + head * 128 + d) = wv; }
        }
    }
}

#define XB_TMO      128
#define XB_XCNT(j)  (256  + 64 * (j))
#define XB_XSUB(j)  (1280 + 64 * (j))
#define XB_XGEN(j)  (2304 + 64 * (j))
#define XB_TOP      3328
#define XB_TOPGEN   3392
#define XCD_BAR_WORDS 3456
#define XB_SPIN_CAP (1u << 20)
__device__ __forceinline__ unsigned xb_ld(unsigned* p)              { return __hip_atomic_load(p, __ATOMIC_RELAXED, __HIP_MEMORY_SCOPE_AGENT); }
__device__ __forceinline__ unsigned xb_add(unsigned* p, unsigned v) { return __hip_atomic_fetch_add(p, v, __ATOMIC_RELAXED, __HIP_MEMORY_SCOPE_AGENT); }
__device__ __forceinline__ unsigned xb_xcc_id() { return (unsigned)__builtin_amdgcn_s_getreg((3 << 11) | 20) & 0xFu; }
#define XB_SPIN(cond, bar) do { unsigned _sp = 0; while (cond) { __builtin_amdgcn_s_sleep(1); \
    if ((++_sp & 255u) == 0u) { if (xb_ld(&(bar)[XB_TMO])) break; if (_sp > XB_SPIN_CAP) { atomicAdd(&(bar)[XB_TMO], 1u); break; } } } } while (0)
struct XcdBarrier { unsigned* bar; unsigned x; volatile LAS unsigned* st; };
__device__ __forceinline__ XcdBarrier xcd_barrier_post(unsigned* bar, volatile LAS unsigned* st) {
    XcdBarrier b; b.bar = bar; b.x = xb_xcc_id(); b.st = st;
    if (threadIdx.x == 0) (void)xb_add(&bar[XB_XCNT(b.x)], 1u);
    return b;
}
__device__ __forceinline__ void xcd_barrier_complete(unsigned* bar, unsigned x, unsigned& nloc, unsigned& nx) {
    const unsigned G = gridDim.x * gridDim.y * gridDim.z;
    unsigned sum, cnt, mine, sp = 0u;
    for (;;) {
        sum = 0u; cnt = 0u; mine = 0u;
#pragma unroll
        for (unsigned j = 0; j < 16; ++j) { const unsigned c = xb_ld(&bar[XB_XCNT(j)]); sum += c; cnt += (c > 0u) ? 1u : 0u; mine = (j == x) ? c : mine; }
        if (sum == G) break;
        __builtin_amdgcn_s_sleep(1);
        if ((++sp & 255u) == 0u) { if (xb_ld(&bar[XB_TMO])) break; if (sp > XB_SPIN_CAP) { atomicAdd(&bar[XB_TMO], 1u); break; } }
    }
    nloc = mine > 0u ? mine : 1u; nx = cnt > 0u ? cnt : 1u;
}
__device__ __forceinline__ void xcd_barrier(const XcdBarrier& b) {
    asm volatile("s_waitcnt vmcnt(0)" ::: "memory");
    __syncthreads();
    if (threadIdx.x == 0) {
        unsigned* bar = b.bar;
        __builtin_amdgcn_s_waitcnt(0);
        unsigned nloc = b.st[0], nx = b.st[1];
        if (nloc == 0u) { xcd_barrier_complete(bar, b.x, nloc, nx); b.st[0] = nloc; b.st[1] = nx; }
        const unsigned old = xb_add(&bar[XB_XSUB(b.x)], 1u);
        const unsigned gen = old / nloc;
        if (old + 1u == (gen + 1u) * nloc) {
            __builtin_amdgcn_fence(__ATOMIC_RELEASE, "agent");
            asm volatile("s_waitcnt vmcnt(0)" ::: "memory");
            const unsigned og = xb_add(&bar[XB_TOP], 1u);
            const unsigned tg = og / nx;
            if (og + 1u == (tg + 1u) * nx) xb_add(&bar[XB_TOPGEN], 1u);
            else XB_SPIN(xb_ld(&bar[XB_TOPGEN]) == tg, bar);
            __builtin_amdgcn_fence(__ATOMIC_ACQUIRE, "agent");
            xb_add(&bar[XB_XGEN(b.x)], 1u);
            asm volatile("s_waitcnt vmcnt(0)" ::: "memory");
        } else {
            XB_SPIN(xb_ld(&bar[XB_XGEN(b.x)]) == gen, bar);
            __builtin_amdgcn_fence(__ATOMIC_ACQUIRE, "agent");
            asm volatile("s_waitcnt vmcnt(0)" ::: "memory");
        }
    }
    __syncthreads();
}

__global__ void __launch_bounds__(512, 2) fwd_megakernel(Params p) {
    extern __shared__ __attribute__((aligned(16))) unsigned char smem[];
    LAS unsigned char* lds = (LAS unsigned char*)smem;
    cg::grid_group grid = cg::this_grid();
    unsigned* barw = (unsigned*)(opq(p.ws) + WS_BAR);
    volatile LAS unsigned* bst = (volatile LAS unsigned*)(lds + LDS_BYTES - 64);
    if (blockIdx.x == 0) for (int i = threadIdx.x; i < XCD_BAR_WORDS; i += 512) barw[i] = 0u;
    if (threadIdx.x < 2) bst[threadIdx.x] = 0u;
#ifndef NO_PRO
    prologue(p, lds);
#endif
    grid.sync();
    const XcdBarrier xbar = xcd_barrier_post(barw, bst);
#define GSYNC() xcd_barrier(xbar)
    const bf16_t* H = (const bf16_t*)(opq(p.ws) + WS_H);
    bf16_t* PROJ = (bf16_t*)(opq(p.ws) + WS_PROJ);
    const bf16_t* GATED = (const bf16_t*)(opq(p.ws) + WS_GATED);
    float* XS = (float*)(opq(p.ws) + WS_XS);
    for (int l = 0; l < 4; ++l) {
        const int j = l >> 1; const bool isna = (l & 1) != 0;
        norm_phase(p, l);
        GSYNC();
        {
            const int N = isna ? NP_NA : NP_RET;
            const bf16_t* Bt = (const bf16_t*)(opq(p.ws) + (isna ? (j ? WS_WNI1 : WS_WNI0) : (j ? WS_WRI1 : WS_WRI0)));
            pg8::Gemm gm{H, Bt, MT, N, DM, DM}; pg8::StaticOrder S; S.init(MT, N, (int)gridDim.x, (int)blockIdx.x);
            pg8::EpiBf16 E{PROJ, N};
#ifndef NO_G1
            pg8::gemm_phase<pg8::EpiBf16, pg8::StaticOrder>(lds, gm, S, E);
#endif
        }
        GSYNC();
#ifndef NO_RETA
        if (!isna) { ret_phaseA(p, j, lds); GSYNC(); ret_phaseB(p); }
#endif
#ifndef NO_NA
        if (isna) na_phase(p, j, l != 3, lds);
#endif
        GSYNC();
        {
            const bf16_t* Bt = (const bf16_t*)(opq(p.ws) + (isna ? (j ? WS_WNO1 : WS_WNO0) : (j ? WS_WRO1 : WS_WRO0)));
            {
                pg8::Gemm gm{GATED, Bt, ML, DM, EB, EB}; pg8::StaticOrder S; S.init(ML, DM, (int)gridDim.x, (int)blockIdx.x);
                pg8::EpiResid E{(l == 0) ? (const float*)opq(p.x) : (const float*)XS, XS, (const float*)(opq(p.ws) + WS_MODV) + (size_t)l * 5 * 6144 + 4096};
                pg8::gemm_phase<pg8::EpiResid, pg8::StaticOrder>(lds, gm, S, E);
            }
            if (l != 3) {
                pg8::Gemm gm{GATED + (size_t)ML * EB, Bt, MC, DM, EB / 8, EB}; pg8::SplitOrder S; S.init(MC, DM, 8, (int)gridDim.x, (int)blockIdx.x);
                pg8::EpiPartial E{(float*)(opq(p.ws) + WS_PART), MC, DM};
                pg8::gemm_phase<pg8::EpiPartial, pg8::SplitOrder>(lds, gm, S, E);
            }
        }
        GSYNC();
    }
    final_norm(p);
}

extern "C" void kernel_launch(void* const* d_in, const int* in_sizes, int n_in, void* d_out, int out_size, void* d_ws, size_t ws_size, hipStream_t stream) {
    static int grid_blocks = 0;
    if (grid_blocks == 0) {
        if (ws_size < WS_END) { fprintf(stderr, "kernel_launch: workspace too small (%zu < %zu)\n", ws_size, (size_t)WS_END); grid_blocks = -1; return; }
        int dev = 0, cus = 0, per_cu = 0;
        hipGetDevice(&dev);
        hipDeviceGetAttribute(&cus, hipDeviceAttributeMultiprocessorCount, dev);
        if (hipFuncSetAttribute((const void*)fwd_megakernel, hipFuncAttributeMaxDynamicSharedMemorySize, LDS_BYTES) != hipSuccess) { fprintf(stderr, "kernel_launch: hipFuncSetAttribute failed\n"); }
        if (hipOccupancyMaxActiveBlocksPerMultiprocessor(&per_cu, (const void*)fwd_megakernel, 512, LDS_BYTES) != hipSuccess || per_cu < 1) { fprintf(stderr, "kernel_launch: occupancy query says %d\n", per_cu); per_cu = 1; }
        (void)hipGetLastError();
        grid_blocks = cus * 1;
        if (grid_blocks <= 0) grid_blocks = 256;
    }
    if (grid_blocks < 0) return;
    Params p{};
    p.x = (const float*)d_in[0]; p.c = (const float*)d_in[1]; p.ctx = (const float*)d_in[2]; p.c_ctx = (const float*)d_in[3];
    p.mod_w = (const float*)d_in[4]; p.mod_b = (const float*)d_in[5]; p.norm_g = (const float*)d_in[6]; p.ret_w_in = (const float*)d_in[7];
    p.ret_df = (const float*)d_in[8]; p.ret_db = (const float*)d_in[9]; p.ret_w_out = (const float*)d_in[10]; p.na_w_in = (const float*)d_in[11];
    p.na_rpb = (const float*)d_in[12]; p.na_w_out = (const float*)d_in[13]; p.final_g = (const float*)d_in[14];
    p.out = (float*)d_out; p.ws = (unsigned char*)d_ws;
    void* args[] = {&p};
    hipError_t e = hipLaunchCooperativeKernel((const void*)fwd_megakernel, dim3(grid_blocks), dim3(512), args, LDS_BYTES, stream);
    if (e != hipSuccess) fprintf(stderr, "cooperative launch failed: %s (grid %d)\n", hipGetErrorString(e), grid_blocks);
}
```

```cpp
#include <hip/hip_runtime.h>
#include <hip/hip_cooperative_groups.h>
#include <cstdio>
namespace cg = cooperative_groups;

#define LAS __attribute__((address_space(3)))
typedef unsigned short bf16_t;
typedef short bf16x8 __attribute__((ext_vector_type(8)));
typedef short s16x4 __attribute__((ext_vector_type(4)));
typedef float f32x4 __attribute__((ext_vector_type(4)));
typedef float f32x2 __attribute__((ext_vector_type(2)));
typedef unsigned u32x4 __attribute__((ext_vector_type(4)));
typedef unsigned u32x2 __attribute__((ext_vector_type(2)));

constexpr int DM = 2048, NB = 4, SEQ = 2048, CTXL = 256, EB = 4096;
constexpr int ML = NB * SEQ, MC = NB * CTXL, MT = ML + MC;
constexpr int NP_RET = 12288, NP_NA = 16384;
constexpr float EPS = 1e-6f;

constexpr size_t MiB = 1u << 20;
constexpr size_t WS_WRI0 = 0, WS_WRI1 = 48 * MiB, WS_WNI0 = 96 * MiB, WS_WNI1 = 160 * MiB;
constexpr size_t WS_WRO0 = 224 * MiB, WS_WRO1 = 240 * MiB, WS_WNO0 = 256 * MiB, WS_WNO1 = 272 * MiB;
constexpr size_t WS_MODV = 288 * MiB, WS_ROPE = 289 * MiB, WS_XS = 290 * MiB, WS_H = 362 * MiB;
constexpr size_t WS_PROJ = 398 * MiB, WS_GATED = 686 * MiB, WS_OFB = 758 * MiB, WS_PART = 902 * MiB, WS_BAR = 966 * MiB, WS_END = 967 * MiB;

constexpr int LDS_BYTES = 147456;

struct Params {
    const float *x, *c, *ctx, *c_ctx, *mod_w, *mod_b, *norm_g, *ret_w_in, *ret_df, *ret_db, *ret_w_out, *na_w_in, *na_rpb, *na_w_out, *final_g;
    float* out; unsigned char* ws;
};

__device__ __forceinline__ unsigned cvt_pk_bf16(float lo, float hi) { unsigned r; asm volatile("v_cvt_pk_bf16_f32 %0, %1, %2" : "=v"(r) : "v"(lo), "v"(hi)); return r; }
__device__ __forceinline__ float bf_lo(unsigned u) { return __uint_as_float(u << 16); }
__device__ __forceinline__ float bf_hi(unsigned u) { return __uint_as_float(u & 0xffff0000u); }
__device__ __forceinline__ float wave_sum(float v) {
#define WS_DPP(ctrl) v += __builtin_bit_cast(float, __builtin_amdgcn_update_dpp(0, __builtin_bit_cast(int, v), (ctrl), 0xf, 0xf, false))
    WS_DPP(0x128); WS_DPP(0x124); WS_DPP(0x122); WS_DPP(0x121);
#undef WS_DPP
    const int vi = __builtin_bit_cast(int, v);
    const float r0 = __builtin_bit_cast(float, __builtin_amdgcn_readlane(vi, 0)), r1 = __builtin_bit_cast(float, __builtin_amdgcn_readlane(vi, 16));
    const float r2 = __builtin_bit_cast(float, __builtin_amdgcn_readlane(vi, 32)), r3 = __builtin_bit_cast(float, __builtin_amdgcn_readlane(vi, 48));
    return (r0 + r1) + (r2 + r3);
}
__device__ __forceinline__ int opaque_tid() { int t = threadIdx.x; asm volatile("" : "+v"(t)); return t; }
template <class T> __device__ __forceinline__ T* opq(T* q) { __attribute__((address_space(1))) T* g = (__attribute__((address_space(1))) T*)q; asm volatile("" : "+s"(g)); return (T*)g; }
__device__ __forceinline__ float silu_f(float v) { return v / (1.0f + __expf(-v)); }
__device__ __forceinline__ s16x4 tr_read(LAS unsigned char* p) {
    typedef short v4i16_t __attribute__((ext_vector_type(4)));
    return __builtin_bit_cast(s16x4, __builtin_amdgcn_ds_read_tr16_b64_v4i16((LAS v4i16_t*)p));
}
__device__ __forceinline__ bf16x8 cat8(s16x4 lo, s16x4 hi) { const u32x2 a = __builtin_bit_cast(u32x2, lo), b = __builtin_bit_cast(u32x2, hi); u32x4 r; r.x = a.x; r.y = a.y; r.z = b.x; r.w = b.y; return __builtin_bit_cast(bf16x8, r); }
__device__ __forceinline__ bf16x8 pack8(f32x4 a, f32x4 b) {
    u32x4 w; w.x = cvt_pk_bf16(a[0], a[1]); w.y = cvt_pk_bf16(a[2], a[3]); w.z = cvt_pk_bf16(b[0], b[1]); w.w = cvt_pk_bf16(b[2], b[3]);
    return __builtin_bit_cast(bf16x8, w);
}

namespace pg8 {
constexpr int BM = 256, BK = 64, HALF = 128, HTB = HALF * BK * 2, STAGE_BYTES = 8 * HTB, NXCD = 8, WGM = 8;
__host__ __device__ __forceinline__ int lds_byte(int r, int c) { const int st = (r >> 4) * 2 + (c >> 5), rr = r & 15, cc = c & 31, ob = rr * 64 + cc * 2; return st * 1024 + (ob ^ (((ob >> 9) & 1) << 5)); }
__host__ __device__ __forceinline__ void stage_rc(int b, int& R, int& C) { const int st = b / 1024, sb = b % 1024, swz = sb ^ (((sb >> 9) & 1) << 5); R = (st >> 1) * 16 + swz / 64; C = (st & 1) * 32 + (swz % 64) / 2; }
__host__ __device__ __forceinline__ int perm32(int rho) { const int n = rho >> 4, i = rho & 15; return 8 * (i >> 2) + 4 * n + (i & 3); }

struct Unit { int pm, pn, ks; };
struct Gemm { const bf16_t* A; const bf16_t* Bt; int M, N, K, ld; };

struct StaticOrder {
    int nM, nN, nwg, G, c;
    __device__ void init(int M, int N, int G_, int c_) { nM = M / BM; nN = N / BM; nwg = nM * nN; G = G_; c = c_; }
    __device__ bool next(int i, Unit& u) const {
        const long L = (long)i * G + c; if (L >= nwg) return false;
        int wgid = (int)L; { const int q = nwg / NXCD, r = nwg % NXCD, xcd = wgid % NXCD, off = wgid / NXCD; wgid = (xcd < r ? xcd * (q + 1) : r * (q + 1) + (xcd - r) * q) + off; }
        const int nig = WGM * nN, gid = wgid / nig, fm = gid * WGM, gsz = (nM - fm) < WGM ? (nM - fm) : WGM;
        u.pm = fm + ((wgid % nig) % gsz); u.pn = (wgid % nig) / gsz; u.ks = 0; return true;
    }
    __device__ __forceinline__ void a_ready(const Unit&) const {}
    __device__ __forceinline__ void done(const Unit&) const {}
};

struct SplitOrder {
    int nM, nN, nS, nwg, G, c;
    __device__ void init(int M, int N, int nS_, int G_, int c_) { nM = M / BM; nN = N / BM; nS = nS_; nwg = nM * nN * nS; G = G_; c = c_; }
    __device__ bool next(int i, Unit& u) const {
        const long L = (long)i * G + c; if (L >= nwg) return false;
        const int l = (int)L; u.ks = l % nS; const int t = l / nS; u.pm = t % nM; u.pn = t / nM; return true;
    }
    __device__ __forceinline__ void a_ready(const Unit&) const {}
    __device__ __forceinline__ void done(const Unit&) const {}
};
struct EpiPartial {
    static constexpr bool PERM = false;
    float* P; int rows, ldc;
    __device__ __forceinline__ void operator()(const f32x4 (&acc)[2][2][4][2], const Unit& u, int wr, int wc, int fr, int fq) const {
        const int row0 = u.pm * BM + wr * 64 + fr, col0 = u.pn * BM + wc * 32 + 4 * fq;
        float* base = P + (size_t)u.ks * rows * ldc;
#pragma unroll
        for (int ai = 0; ai < 2; ++ai)
#pragma unroll
            for (int m = 0; m < 4; ++m) { float* rowp = base + (size_t)(row0 + ai * HALF + m * 16) * ldc + col0;
#pragma unroll
                for (int bj = 0; bj < 2; ++bj)
#pragma unroll
                    for (int n = 0; n < 2; ++n) *(f32x4*)(rowp + bj * HALF + n * 16) = acc[ai][bj][m][n]; }
    }
};
struct EpiBf16 {
    static constexpr bool PERM = true;
    bf16_t* O; int ldc;
    __device__ __forceinline__ void operator()(const f32x4 (&acc)[2][2][4][2], const Unit& u, int wr, int wc, int fr, int fq) const {
        const int row0 = u.pm * BM + wr * 64 + fr; const int col0 = u.pn * BM + wc * 32 + 8 * fq;
#pragma unroll
        for (int ai = 0; ai < 2; ++ai)
#pragma unroll
            for (int m = 0; m < 4; ++m) { bf16_t* rowp = O + (size_t)(row0 + ai * HALF + m * 16) * ldc + col0;
#pragma unroll
                for (int bj = 0; bj < 2; ++bj) { const f32x4 v0 = acc[ai][bj][m][0], v1 = acc[ai][bj][m][1];
                    u32x4 w; w.x = cvt_pk_bf16(v0[0], v0[1]); w.y = cvt_pk_bf16(v0[2], v0[3]); w.z = cvt_pk_bf16(v1[0], v1[1]); w.w = cvt_pk_bf16(v1[2], v1[3]);
                    *(u32x4*)(rowp + bj * HALF) = w; } }
    }
};
struct EpiResid {
    static constexpr bool PERM = false;
    const float* xsrc; float* xout; const float* gt_base;
    __device__ __forceinline__ void operator()(const f32x4 (&acc)[2][2][4][2], const Unit& u, int wr, int wc, int fr, int fq) const {
        const int row0 = u.pm * BM + wr * 64 + fr, col0 = u.pn * BM + wc * 32 + 4 * fq;
        const int mrow = (u.pm * BM < ML) ? ((u.pm * BM) >> 11) : 4;
        const float* gt = gt_base + mrow * 6144;
        f32x4 gv[2][2];
#pragma unroll
        for (int bj = 0; bj < 2; ++bj)
#pragma unroll
            for (int n = 0; n < 2; ++n) gv[bj][n] = *(const f32x4*)(gt + col0 + bj * HALF + n * 16);
#pragma unroll
        for (int ai = 0; ai < 2; ++ai) {
            f32x4 xv[4][2][2];
#pragma unroll
            for (int m = 0; m < 4; ++m) { const float* sp = xsrc + (size_t)(row0 + ai * HALF + m * 16) * DM;
#pragma unroll
                for (int bj = 0; bj < 2; ++bj)
#pragma unroll
                    for (int n = 0; n < 2; ++n) xv[m][bj][n] = *(const f32x4*)(sp + col0 + bj * HALF + n * 16); }
#pragma unroll
            for (int m = 0; m < 4; ++m) { float* dp = xout + (size_t)(row0 + ai * HALF + m * 16) * DM;
#pragma unroll
                for (int bj = 0; bj < 2; ++bj)
#pragma unroll
                    for (int n = 0; n < 2; ++n) *(f32x4*)(dp + col0 + bj * HALF + n * 16) = xv[m][bj][n] + gv[bj][n] * acc[ai][bj][m][n]; }
        }
    }
};

template <class Epi, class Sched, bool ALIGN_EPI = true, bool SP2 = true>
__device__ __forceinline__ void gemm_phase(LAS unsigned char* lds, const Gemm g, const Sched& S, const Epi& E) {
    const int tid = opaque_tid(), wid = __builtin_amdgcn_readfirstlane(tid >> 6), lane = tid & 63, wr = wid >> 2, wc = wid & 3, fr = lane & 15, fq = lane >> 4;
    const int K = g.ld, nt = g.K / BK;
    unsigned voffA[2], voffB[2];
#pragma unroll
    for (int i = 0; i < 2; ++i) { int R, C; stage_rc(tid * 16 + i * 8192, R, C); const int Rb = Epi::PERM ? ((R & ~31) + perm32(R & 31)) : R;
        voffA[i] = (unsigned)(R * K + C) * 2u; voffB[i] = (unsigned)(Rb * K + C) * 2u; }
    const size_t kstep = (size_t)(BK * 2);
    const size_t hstep = (size_t)HALF * K * 2;
    const size_t tstep = 2 * hstep;
    const unsigned ldsw = (unsigned)wid * 1024u;
    const int aoff = lds_byte(wr * 64 + fr, fq * 8), boff = lds_byte(wc * 32 + fr, fq * 8);
#define PG8_SA(b, h) (((b) * 2 + (h)) * HTB)
#define PG8_SB(b, h) ((4 + (b) * 2 + (h)) * HTB)
#define PG8_STAGE(bufoff, gbase, voff) do { _Pragma("unroll") for (int _i = 0; _i < 2; ++_i) \
        __builtin_amdgcn_global_load_lds((const unsigned*)((const char*)(gbase) + (voff)[_i]), (LAS unsigned*)(lds + (bufoff) + ldsw + _i * 8192), 16, 0, 0); } while (0)
#define PG8_LDA(dst, b, h) do { _Pragma("unroll") for (int m = 0; m < 4; ++m) _Pragma("unroll") for (int k = 0; k < 2; ++k) dst[m][k] = *(const LAS bf16x8*)(lds + PG8_SA(b, h) + aoff + m * 2048 + k * 1024); } while (0)
#define PG8_LDB(dst, b, h) do { _Pragma("unroll") for (int n = 0; n < 2; ++n) _Pragma("unroll") for (int k = 0; k < 2; ++k) dst[n][k] = *(const LAS bf16x8*)(lds + PG8_SB(b, h) + boff + n * 2048 + k * 1024); } while (0)
#define PG8_MMA(ai, bj, At, Bt) do { __builtin_amdgcn_s_setprio(1); _Pragma("unroll") for (int m = 0; m < 4; ++m) _Pragma("unroll") for (int n = 0; n < 2; ++n) _Pragma("unroll") for (int k = 0; k < 2; ++k) \
        acc[ai][bj][m][n] = __builtin_amdgcn_mfma_f32_16x16x32_bf16(Bt[n][k], At[m][k], acc[ai][bj][m][n], 0, 0, 0); __builtin_amdgcn_s_setprio(0); } while (0)
#define PG8_WAIT_V(n) asm volatile("s_waitcnt vmcnt(" #n ")" ::: "memory")
#define PG8_WAIT_L(n) asm volatile("s_waitcnt lgkmcnt(" #n ")" ::: "memory")
#define PG8_BAR __builtin_amdgcn_s_barrier()
#define PG8_SCHED __builtin_amdgcn_sched_barrier(0)
    Unit cur, nxt; int ui = 0;
    if (!S.next(0, cur)) return;
    f32x4 acc[2][2][4][2];
#pragma unroll
    for (int a = 0; a < 2; ++a)
#pragma unroll
        for (int b = 0; b < 2; ++b)
#pragma unroll
            for (int m = 0; m < 4; ++m)
#pragma unroll
                for (int n = 0; n < 2; ++n) acc[a][b][m][n] = (f32x4){0.f, 0.f, 0.f, 0.f};
    bf16x8 At[4][2], B0[2][2], B1[2][2];
    const size_t ksb = (size_t)g.K * 2;
    const char* cA = (const char*)g.A + (size_t)cur.pm * tstep + cur.ks * ksb; const char* cB = (const char*)g.Bt + (size_t)cur.pn * tstep + cur.ks * ksb;
    S.a_ready(cur);
    if constexpr (SP2) {
        PG8_STAGE(PG8_SB(0, 0), cB, voffB); PG8_STAGE(PG8_SB(0, 1), cB + hstep, voffB); PG8_STAGE(PG8_SA(0, 0), cA, voffA); PG8_STAGE(PG8_SA(0, 1), cA + hstep, voffA);
        if (wr == 1) PG8_BAR;
        PG8_WAIT_V(2); PG8_BAR;
        PG8_STAGE(PG8_SB(1, 0), cB + kstep, voffB); PG8_STAGE(PG8_SA(1, 0), cA + kstep, voffA); PG8_STAGE(PG8_SB(1, 1), cB + hstep + kstep, voffB);
        PG8_WAIT_V(6); PG8_BAR;
    } else {
        PG8_STAGE(PG8_SB(0, 0), cB, voffB); PG8_STAGE(PG8_SA(0, 0), cA, voffA); PG8_STAGE(PG8_SB(0, 1), cB + hstep, voffB); PG8_STAGE(PG8_SA(0, 1), cA + hstep, voffA);
        if (wr == 1) PG8_BAR;
        PG8_WAIT_V(4); PG8_BAR;
        PG8_STAGE(PG8_SB(1, 0), cB + kstep, voffB); PG8_STAGE(PG8_SA(1, 0), cA + kstep, voffA); PG8_STAGE(PG8_SB(1, 1), cB + hstep + kstep, voffB);
        PG8_WAIT_V(6); PG8_BAR;
    }
    for (;;) {
        const bool has_next = S.next(ui + 1, nxt);
        const char* nA = has_next ? (const char*)g.A + (size_t)nxt.pm * tstep + nxt.ks * ksb : cA; const char* nB = has_next ? (const char*)g.Bt + (size_t)nxt.pn * tstep + nxt.ks * ksb : cB;
        for (int t = 0; t < nt; t += 2) {
            const bool last = (t == nt - 2);
            const char* a1 = cA + (size_t)(t + 1) * kstep;
            const char* a2 = last ? nA : cA + (size_t)(t + 2) * kstep; const char* b2 = last ? nB : cB + (size_t)(t + 2) * kstep;
            const char* a3 = a2 + kstep; const char* b3 = b2 + kstep;
            if (last && has_next) S.a_ready(nxt);
            if constexpr (SP2) {
            PG8_LDB(B0, 0, 0); PG8_LDB(B1, 0, 1); PG8_SCHED; PG8_LDA(At, 0, 0); PG8_STAGE(PG8_SA(1, 1), a1 + hstep, voffA);
            PG8_WAIT_V(8); PG8_WAIT_L(0); PG8_BAR; PG8_MMA(0, 0, At, B0); PG8_MMA(0, 1, At, B1); PG8_BAR; PG8_SCHED;
            PG8_LDA(At, 0, 1); PG8_STAGE(PG8_SB(0, 0), b2, voffB); PG8_STAGE(PG8_SB(0, 1), b2 + hstep, voffB); PG8_STAGE(PG8_SA(0, 0), a2, voffA);
            PG8_WAIT_V(8); PG8_WAIT_L(0); PG8_BAR; PG8_MMA(1, 0, At, B0); PG8_MMA(1, 1, At, B1); PG8_BAR; PG8_SCHED;
            PG8_LDB(B0, 1, 0); PG8_LDB(B1, 1, 1); PG8_SCHED; PG8_LDA(At, 1, 0); PG8_STAGE(PG8_SA(0, 1), a2 + hstep, voffA);
            PG8_WAIT_V(8); PG8_WAIT_L(0); PG8_BAR; PG8_MMA(0, 0, At, B0); PG8_MMA(0, 1, At, B1); PG8_BAR; PG8_SCHED;
            PG8_LDA(At, 1, 1); PG8_STAGE(PG8_SB(1, 0), b3, voffB); PG8_STAGE(PG8_SB(1, 1), b3 + hstep, voffB); PG8_STAGE(PG8_SA(1, 0), a3, voffA);
            PG8_WAIT_V(8); PG8_WAIT_L(0); PG8_BAR; PG8_MMA(1, 0, At, B0); PG8_MMA(1, 1, At, B1); PG8_BAR; PG8_SCHED;
            } else {
            PG8_LDB(B0, 0, 0); PG8_SCHED; PG8_LDA(At, 0, 0); PG8_STAGE(PG8_SA(1, 1), a1 + hstep, voffA);
            PG8_WAIT_L(8); PG8_BAR; PG8_WAIT_L(0); PG8_MMA(0, 0, At, B0); PG8_BAR; PG8_SCHED;
            PG8_LDB(B1, 0, 1); PG8_STAGE(PG8_SB(0, 0), b2, voffB);
            PG8_BAR; PG8_WAIT_L(0); PG8_MMA(0, 1, At, B1); PG8_BAR;
            PG8_LDA(At, 0, 1); PG8_STAGE(PG8_SA(0, 0), a2, voffA);
            PG8_BAR; PG8_WAIT_L(0); PG8_MMA(1, 0, At, B0); PG8_BAR; PG8_SCHED;
            PG8_STAGE(PG8_SB(0, 1), b2 + hstep, voffB);
            PG8_WAIT_V(6); PG8_BAR; PG8_MMA(1, 1, At, B1); PG8_BAR;
            PG8_LDB(B0, 1, 0); PG8_SCHED; PG8_LDA(At, 1, 0); PG8_STAGE(PG8_SA(0, 1), a2 + hstep, voffA);
            PG8_WAIT_L(8); PG8_BAR; PG8_WAIT_L(0); PG8_MMA(0, 0, At, B0); PG8_BAR; PG8_SCHED;
            PG8_LDB(B1, 1, 1); PG8_STAGE(PG8_SB(1, 0), b3, voffB);
            PG8_BAR; PG8_WAIT_L(0); PG8_MMA(0, 1, At, B1); PG8_BAR;
            PG8_LDA(At, 1, 1); PG8_STAGE(PG8_SA(1, 0), a3, voffA);
            PG8_BAR; PG8_WAIT_L(0); PG8_MMA(1, 0, At, B0); PG8_BAR; PG8_SCHED;
            PG8_STAGE(PG8_SB(1, 1), b3 + hstep, voffB);
            PG8_WAIT_V(6); PG8_BAR; PG8_MMA(1, 1, At, B1); PG8_BAR;
            }
        }
        if constexpr (ALIGN_EPI) { if (wr == 0) PG8_BAR; }
        E(acc, cur, wr, wc, fr, fq); S.done(cur);
        if (!has_next) break;
#pragma unroll
        for (int a = 0; a < 2; ++a)
#pragma unroll
            for (int b = 0; b < 2; ++b)
#pragma unroll
                for (int m = 0; m < 4; ++m)
#pragma unroll
                    for (int n = 0; n < 2; ++n) acc[a][b][m][n] = (f32x4){0.f, 0.f, 0.f, 0.f};
        cur = nxt; cA = nA; cB = nB; ++ui;
        if constexpr (ALIGN_EPI) { if (wr == 1) PG8_BAR; }
    }
    PG8_WAIT_V(0);
    if constexpr (!ALIGN_EPI) { if (wr == 0) PG8_BAR; }
    PG8_BAR;
#undef PG8_SA
#undef PG8_SB
#undef PG8_STAGE
#undef PG8_LDA
#undef PG8_LDB
#undef PG8_MMA
#undef PG8_WAIT_V
#undef PG8_WAIT_L
#undef PG8_BAR
#undef PG8_SCHED
}
}

__device__ __forceinline__ void transpose_item(const float* W, int K, int N, bf16_t* WT, LAS float* scr, int item, int lane) {
    const int nblk = N >> 6, kb = item / nblk, nb = item - kb * nblk, k0 = kb * 64, n0 = nb * 64;
    const float* src = W + (size_t)k0 * N + n0 + lane;
#pragma unroll 16
    for (int i = 0; i < 64; ++i) scr[i * 65 + lane] = __builtin_nontemporal_load(src + (size_t)i * N);
    asm volatile("s_waitcnt lgkmcnt(0)" ::: "memory");
    const int c = lane & 7;
#pragma unroll
    for (int j = 0; j < 8; ++j) { const int n = (lane >> 3) + 8 * j; const LAS float* s = scr + (8 * c) * 65 + n;
        u32x4 o; o.x = cvt_pk_bf16(s[0], s[65]); o.y = cvt_pk_bf16(s[2 * 65], s[3 * 65]); o.z = cvt_pk_bf16(s[4 * 65], s[5 * 65]); o.w = cvt_pk_bf16(s[6 * 65], s[7 * 65]);
        *(u32x4*)(WT + (size_t)(n0 + n) * K + k0 + 8 * c) = o; }
    asm volatile("s_waitcnt lgkmcnt(0)" ::: "memory");
}

__device__ __forceinline__ void prologue(const Params& p, LAS unsigned char* lds) {
    unsigned char* ws_ = opq(p.ws);
    const int tid = opaque_tid(), lane = tid & 63, wave = tid >> 6;
    LAS float* cs = (LAS float*)lds;
    LAS float* red = (LAS float*)(lds + 40960);
    for (int i = tid; i < 5 * DM; i += 512) { const float v = (i < 4 * DM) ? opq(p.c)[i] : opq(p.c_ctx)[i - 4 * DM]; cs[i] = v / (1.0f + expf(-v)); }
    __syncthreads();
    float* modv = (float*)(ws_ + WS_MODV);
    for (int item = blockIdx.x; item < 384; item += gridDim.x) {
        const int l = item / 96, cgp = item - l * 96;
        const float* W = opq(p.mod_w) + (size_t)l * DM * 6144 + cgp * 64 + lane;
        float a0 = 0.f, a1 = 0.f, a2 = 0.f, a3 = 0.f, a4 = 0.f;
        const int k0 = wave * 256;
#pragma unroll 8
        for (int k = k0; k < k0 + 256; ++k) { const float w = __builtin_nontemporal_load(W + (size_t)k * 6144); a0 += cs[k] * w; a1 += cs[DM + k] * w; a2 += cs[2 * DM + k] * w; a3 += cs[3 * DM + k] * w; a4 += cs[4 * DM + k] * w; }
        red[(wave * 5 + 0) * 64 + lane] = a0; red[(wave * 5 + 1) * 64 + lane] = a1; red[(wave * 5 + 2) * 64 + lane] = a2; red[(wave * 5 + 3) * 64 + lane] = a3; red[(wave * 5 + 4) * 64 + lane] = a4;
        __syncthreads();
        if (tid < 320) { const int r = tid >> 6; float s = 0.f;
#pragma unroll
            for (int w = 0; w < 8; ++w) s += red[(w * 5 + r) * 64 + lane];
            modv[(size_t)(l * 5 + r) * 6144 + cgp * 64 + lane] = s + opq(p.mod_b)[l * 6144 + cgp * 64 + lane]; }
        __syncthreads();
    }
    {
        const int gt = blockIdx.x * 512 + tid;
        if (gt < 4096) { const int pos = gt >> 6, f = gt & 63; const float freq = exp2f(-(float)f * (13.287712379549449f / 64.0f)); const float ang = (float)pos * freq;
            float sn, cn; sincosf(ang, &sn, &cn); ((f32x2*)(ws_ + WS_ROPE))[gt] = (f32x2){cn, sn}; }
    }
    __syncthreads();
    LAS float* scr = (LAS float*)(lds + wave * 16640);
    const int gw = blockIdx.x * 8 + wave, NGW = gridDim.x * 8;
    constexpr int I_RI = 32 * 192, I_NI = 32 * 256, I_O = 64 * 32;
    constexpr int NITEMS = 2 * I_RI + 2 * I_NI + 4 * I_O;
    for (int it = gw; it < NITEMS; it += NGW) {
        int r = it;
        if (r < I_RI) { transpose_item(opq(p.ret_w_in), DM, NP_RET, (bf16_t*)(ws_ + WS_WRI0), scr, r, lane); continue; } r -= I_RI;
        if (r < I_O) { transpose_item(opq(p.ret_w_out), EB, DM, (bf16_t*)(ws_ + WS_WRO0), scr, r, lane); continue; } r -= I_O;
        if (r < I_NI) { transpose_item(opq(p.na_w_in), DM, NP_NA, (bf16_t*)(ws_ + WS_WNI0), scr, r, lane); continue; } r -= I_NI;
        if (r < I_O) { transpose_item(opq(p.na_w_out), EB, DM, (bf16_t*)(ws_ + WS_WNO0), scr, r, lane); continue; } r -= I_O;
        if (r < I_RI) { transpose_item(opq(p.ret_w_in) + (size_t)DM * NP_RET, DM, NP_RET, (bf16_t*)(ws_ + WS_WRI1), scr, r, lane); continue; } r -= I_RI;
        if (r < I_O) { transpose_item(opq(p.ret_w_out) + (size_t)EB * DM, EB, DM, (bf16_t*)(ws_ + WS_WRO1), scr, r, lane); continue; } r -= I_O;
        if (r < I_NI) { transpose_item(opq(p.na_w_in) + (size_t)DM * NP_NA, DM, NP_NA, (bf16_t*)(ws_ + WS_WNI1), scr, r, lane); continue; } r -= I_NI;
        transpose_item(opq(p.na_w_out) + (size_t)EB * DM, EB, DM, (bf16_t*)(ws_ + WS_WNO1), scr, r, lane);
    }
    __syncthreads();
}

__device__ __forceinline__ void norm_emit(const f32x4 (&v)[8], const f32x4 (&gs)[8], const f32x4 (&sh)[8], bf16_t* hrow, int lane) {
    float ss = 0.f;
#pragma unroll
    for (int j = 0; j < 8; ++j) ss += (v[j][0] * v[j][0] + v[j][1] * v[j][1]) + (v[j][2] * v[j][2] + v[j][3] * v[j][3]);
    ss = wave_sum(ss);
    const float rstd = 1.0f / sqrtf(ss * (1.0f / DM) + EPS);
    u32x2* o = (u32x2*)hrow;
#pragma unroll
    for (int j = 0; j < 8; ++j) { const f32x4 hv = v[j] * rstd * gs[j] + sh[j];
        u32x2 w; w.x = cvt_pk_bf16(hv[0], hv[1]); w.y = cvt_pk_bf16(hv[2], hv[3]); o[lane + 64 * j] = w; }
}
__device__ __forceinline__ void norm_phase(const Params& p, int l) {
    unsigned char* ws_ = opq(p.ws);
    const int tid = opaque_tid(), lane = tid & 63, wave = tid >> 6;
    const int gw = blockIdx.x * 8 + wave, NGW = gridDim.x * 8;
    float* XS = (float*)(ws_ + WS_XS);
    const float* modv = (const float*)(ws_ + WS_MODV);
    const float* PART = (const float*)(ws_ + WS_PART);
    bf16_t* H = (bf16_t*)(ws_ + WS_H);
    const f32x4* g4 = (const f32x4*)(opq(p.norm_g) + l * DM);
    f32x4 gg[8];
#pragma unroll
    for (int j = 0; j < 8; ++j) gg[j] = g4[lane + 64 * j];
    for (int m = ML + gw; m < MT; m += NGW) {
        const float* src = (l <= 1) ? opq(p.ctx) + (size_t)(m - ML) * DM : XS + (size_t)m * DM;
        const f32x4* sh4 = (const f32x4*)(modv + (size_t)(l * 5 + 4) * 6144);
        f32x4 v[8], gs[8], sh[8];
#pragma unroll
        for (int j = 0; j < 8; ++j) { v[j] = ((const f32x4*)src)[lane + 64 * j]; gs[j] = gg[j] * (sh4[DM / 4 + lane + 64 * j] + 1.0f); sh[j] = sh4[lane + 64 * j]; }
        if (l != 0) {
            const f32x4* gt4 = (const f32x4*)(modv + (size_t)((l - 1) * 5 + 4) * 6144 + 4096);
            const f32x4* pp = (const f32x4*)(PART + (size_t)(m - ML) * DM);
#pragma unroll
            for (int j = 0; j < 8; ++j) { f32x4 a = (f32x4){0.f, 0.f, 0.f, 0.f};
#pragma unroll
                for (int sp = 0; sp < 8; ++sp) a += pp[(size_t)sp * (MC * DM / 4) + lane + 64 * j];
                v[j] += gt4[lane + 64 * j] * a; }
#pragma unroll
            for (int j = 0; j < 8; ++j) ((f32x4*)(XS + (size_t)m * DM))[lane + 64 * j] = v[j];
        }
        norm_emit(v, gs, sh, H + (size_t)m * DM, lane);
    }
    const float* lsrc = (l == 0) ? opq(p.x) : (const float*)XS;
    int pstart = gw, pend = ML / 2, pstep = NGW;
    if (l > 0 && NGW == 2048) { if (gw < 1024) { pstart = gw; pend = gw + 1; } else { pstart = 1024 + (gw - 1024) * 3; pend = pstart + 3; } pstep = 1; }
    for (int pi = pstart; pi < pend; pi += pstep) {
        const int m0 = pi * 2;
        const f32x4* sh4 = (const f32x4*)(modv + (size_t)(l * 5 + (m0 >> 11)) * 6144);
        f32x4 va[8], vb[8], gs[8], sh[8];
#pragma unroll
        for (int j = 0; j < 8; ++j) { va[j] = ((const f32x4*)(lsrc + (size_t)m0 * DM))[lane + 64 * j]; vb[j] = ((const f32x4*)(lsrc + (size_t)(m0 + 1) * DM))[lane + 64 * j];
            gs[j] = gg[j] * (sh4[DM / 4 + lane + 64 * j] + 1.0f); sh[j] = sh4[lane + 64 * j]; }
        norm_emit(va, gs, sh, H + (size_t)m0 * DM, lane);
        norm_emit(vb, gs, sh, H + (size_t)(m0 + 1) * DM, lane);
    }
}
__device__ __forceinline__ void final_norm(const Params& p) {
    unsigned char* ws_ = opq(p.ws);
    const int tid = opaque_tid(), lane = tid & 63, wave = tid >> 6;
    const int gw = blockIdx.x * 8 + wave, NGW = gridDim.x * 8;
    const float* XS = (const float*)(ws_ + WS_XS);
    const f32x4* g4 = (const f32x4*)opq(p.final_g);
    float* outp = opq(p.out);
    f32x4 gg[8];
#pragma unroll
    for (int j = 0; j < 8; ++j) gg[j] = g4[lane + 64 * j];
    for (int m0 = gw * 2; m0 < ML; m0 += NGW * 2) {
        f32x4 v[2][8];
#pragma unroll
        for (int q = 0; q < 2; ++q)
#pragma unroll
            for (int j = 0; j < 8; ++j) v[q][j] = ((const f32x4*)(XS + (size_t)(m0 + q) * DM))[lane + 64 * j];
#pragma unroll
        for (int q = 0; q < 2; ++q) { float ss = 0.f;
#pragma unroll
            for (int j = 0; j < 8; ++j) ss += (v[q][j][0] * v[q][j][0] + v[q][j][1] * v[q][j][1]) + (v[q][j][2] * v[q][j][2] + v[q][j][3] * v[q][j][3]);
            ss = wave_sum(ss);
            const float rstd = 1.0f / sqrtf(ss * (1.0f / DM) + EPS);
            f32x4* o = (f32x4*)(outp + (size_t)(m0 + q) * DM);
#pragma unroll
            for (int j = 0; j < 8; ++j) o[lane + 64 * j] = v[q][j] * rstd * gg[j];
        }
    }
}

constexpr int RQ_STRIDE = 528, RK_STRIDE = 544, RV_STRIDE = 288, RP_STRIDE = 144;
constexpr int R_QS = 0, R_KS = 33792, R_VS = 68608, R_PS = 87040;
__device__ __forceinline__ void ret_phaseA(const Params& p, int j, LAS unsigned char* lds) {
    unsigned char* ws_ = opq(p.ws);
    const int tid = opaque_tid(), lane = tid & 63, w = __builtin_amdgcn_readfirstlane(tid >> 6), g = lane >> 4, li = lane & 15;
    const int tq = li >> 2, tp = li & 3;
    const bf16_t* PROJ = (const bf16_t*)(ws_ + WS_PROJ);
    bf16_t* OFB = (bf16_t*)(ws_ + WS_OFB);
    const f32x2* rope = (const f32x2*)(ws_ + WS_ROPE);
    LAS unsigned char* Qs = lds + R_QS; LAS unsigned char* Ks = lds + R_KS; LAS unsigned char* Vs = lds + R_VS; LAS unsigned char* Ps = lds + R_PS;
    for (int u = blockIdx.x; u < 256; u += gridDim.x) {
        const int slice = (u >> 3) & 3, grp = (u & 7) | ((u >> 5) << 3), dir = grp & 1, h = (grp >> 1) & 7, b = grp >> 4;
        const float raw = (dir ? opq(p.ret_db) : opq(p.ret_df))[j * 8 + h];
        const float lg = -log1pf(expf(raw));
        const float cdec = expf(lg * 64.0f);
        f32x4 S[16];
#pragma unroll
        for (int i = 0; i < 16; ++i) S[i] = (f32x4){0.f, 0.f, 0.f, 0.f};
        u32x4 pq[2][2], pk[2][2], pv[2];
#define RET_ROWBASE(s, rb, cc, isctx) do { isctx = (s) < 4; const int ci_ = isctx ? (s) : (s) - 4; const int nch_ = isctx ? 4 : 32; cc = dir ? nch_ - 1 - ci_ : ci_; \
        rb = isctx ? ML + b * CTXL + cc * 64 : b * SEQ + cc * 64; } while (0)
#define RET_LOAD(s) do { int rb_, cc_; bool ic_; RET_ROWBASE(s, rb_, cc_, ic_); _Pragma("unroll") for (int t = 0; t < 2; ++t) { const int tk = tid + 512 * t; const int row = tk >> 4, sub = tk & 15; \
        const int d0 = (sub >> 3) * 128 + (sub & 7) * 8; const bf16_t* sp = PROJ + (size_t)(rb_ + row) * NP_RET + h * 256 + d0; \
        pq[t][0] = *(const u32x4*)sp; pq[t][1] = *(const u32x4*)(sp + 64); pk[t][0] = *(const u32x4*)(sp + 2048); pk[t][1] = *(const u32x4*)(sp + 2048 + 64); \
        pv[t] = *(const u32x4*)(PROJ + (size_t)(rb_ + row) * NP_RET + 4096 + h * 512 + slice * 128 + sub * 8); } } while (0)
        RET_LOAD(0);
        for (int s = 0; s < 36; ++s) {
            int rowbase, cc; bool isctx; RET_ROWBASE(s, rowbase, cc, isctx);
#pragma unroll
            for (int t = 0; t < 2; ++t) {
                const int tk = tid + 512 * t; const int row = tk >> 4, sub = tk & 15; const int half = sub >> 3, gq = sub & 7; const int d0 = half * 128 + gq * 8;
                const float e_i = dir ? (float)(64 - row) : (float)(row + 1);
                const float fqs = expf(lg * e_i), fks = expf(-lg * e_i) * 0.0625f;
                float q1[8], q2[8], k1[8], k2[8];
#pragma unroll
                for (int e = 0; e < 4; ++e) { q1[2 * e] = bf_lo(pq[t][0][e]); q1[2 * e + 1] = bf_hi(pq[t][0][e]); q2[2 * e] = bf_lo(pq[t][1][e]); q2[2 * e + 1] = bf_hi(pq[t][1][e]);
                    k1[2 * e] = bf_lo(pk[t][0][e]); k1[2 * e + 1] = bf_hi(pk[t][0][e]); k2[2 * e] = bf_lo(pk[t][1][e]); k2[2 * e + 1] = bf_hi(pk[t][1][e]); }
                if (!isctx) {
                    const int pos = half ? row : cc;
                    const f32x4* rp = (const f32x4*)(rope + pos * 64 + gq * 8);
#pragma unroll
                    for (int e = 0; e < 4; ++e) { const f32x4 cs2 = rp[e];
                        { const float c0 = cs2[0], s0 = cs2[1]; const float a = q1[2 * e], bb = q2[2 * e]; q1[2 * e] = a * c0 - bb * s0; q2[2 * e] = a * s0 + bb * c0;
                          const float ka = k1[2 * e], kb = k2[2 * e]; k1[2 * e] = ka * c0 - kb * s0; k2[2 * e] = ka * s0 + kb * c0; }
                        { const float c0 = cs2[2], s0 = cs2[3]; const float a = q1[2 * e + 1], bb = q2[2 * e + 1]; q1[2 * e + 1] = a * c0 - bb * s0; q2[2 * e + 1] = a * s0 + bb * c0;
                          const float ka = k1[2 * e + 1], kb = k2[2 * e + 1]; k1[2 * e + 1] = ka * c0 - kb * s0; k2[2 * e + 1] = ka * s0 + kb * c0; } }
                }
                u32x4 o;
                o.x = cvt_pk_bf16(q1[0] * fqs, q1[1] * fqs); o.y = cvt_pk_bf16(q1[2] * fqs, q1[3] * fqs); o.z = cvt_pk_bf16(q1[4] * fqs, q1[5] * fqs); o.w = cvt_pk_bf16(q1[6] * fqs, q1[7] * fqs);
                *(LAS u32x4*)(Qs + row * RQ_STRIDE + d0 * 2) = o;
                o.x = cvt_pk_bf16(q2[0] * fqs, q2[1] * fqs); o.y = cvt_pk_bf16(q2[2] * fqs, q2[3] * fqs); o.z = cvt_pk_bf16(q2[4] * fqs, q2[5] * fqs); o.w = cvt_pk_bf16(q2[6] * fqs, q2[7] * fqs);
                *(LAS u32x4*)(Qs + row * RQ_STRIDE + (d0 + 64) * 2) = o;
                o.x = cvt_pk_bf16(k1[0] * fks, k1[1] * fks); o.y = cvt_pk_bf16(k1[2] * fks, k1[3] * fks); o.z = cvt_pk_bf16(k1[4] * fks, k1[5] * fks); o.w = cvt_pk_bf16(k1[6] * fks, k1[7] * fks);
                *(LAS u32x4*)(Ks + row * RK_STRIDE + d0 * 2) = o;
                o.x = cvt_pk_bf16(k2[0] * fks, k2[1] * fks); o.y = cvt_pk_bf16(k2[2] * fks, k2[3] * fks); o.z = cvt_pk_bf16(k2[4] * fks, k2[5] * fks); o.w = cvt_pk_bf16(k2[6] * fks, k2[7] * fks);
                *(LAS u32x4*)(Ks + row * RK_STRIDE + (d0 + 64) * 2) = o;
                *(LAS u32x4*)(Vs + row * RV_STRIDE + sub * 16) = pv[t];
            }
            __syncthreads();
            if (s + 1 < 36) RET_LOAD(s + 1);
            {
                const int ib = w >> 1;
#pragma unroll
                for (int t = 0; t < 2; ++t) {
                    const int jb = 2 * (w & 1) + t;
                    f32x4 acc = (f32x4){0.f, 0.f, 0.f, 0.f};
                    const bool nz = dir ? (jb >= ib) : (jb <= ib);
                    if (nz) {
                        const LAS unsigned char* kp_ = Ks + (jb * 16 + li) * RK_STRIDE + (8 * g) * 2; const LAS unsigned char* qp_ = Qs + (ib * 16 + li) * RQ_STRIDE + (8 * g) * 2;
                        bf16x8 na_ = *(const LAS bf16x8*)kp_, nb_ = *(const LAS bf16x8*)qp_, na2_ = *(const LAS bf16x8*)(kp_ + 64), nb2_ = *(const LAS bf16x8*)(qp_ + 64);
#pragma unroll
                        for (int kk = 0; kk < 8; ++kk) {
                            const bf16x8 a = na_, bq = nb_; na_ = na2_; nb_ = nb2_;
                            if (kk + 2 < 8) { na2_ = *(const LAS bf16x8*)(kp_ + (kk + 2) * 64); nb2_ = *(const LAS bf16x8*)(qp_ + (kk + 2) * 64); }
                            acc = __builtin_amdgcn_mfma_f32_16x16x32_bf16(a, bq, acc, 0, 0, 0);
                            __builtin_amdgcn_sched_barrier(0);
                        }
                        const int i = ib * 16 + li;
#pragma unroll
                        for (int r = 0; r < 4; ++r) { const int jj = jb * 16 + 4 * g + r; const bool keep = dir ? (jj >= i) : (jj <= i); acc[r] = keep ? acc[r] : 0.f; }
                    }
                    u32x2 wv; wv.x = cvt_pk_bf16(acc[0], acc[1]); wv.y = cvt_pk_bf16(acc[2], acc[3]);
                    *(LAS u32x2*)(Ps + (ib * 16 + li) * RP_STRIDE + (jb * 16 + 4 * g) * 2) = wv;
                }
            }
            f32x4 oacc[4];
#pragma unroll
            for (int ib = 0; ib < 4; ++ib) oacc[ib] = (f32x4){0.f, 0.f, 0.f, 0.f};
            {
                const LAS unsigned char* qa0 = Qs + li * RQ_STRIDE + (4 * g) * 2;
#define RET_QF(idx) cat8(*(const LAS s16x4*)(qa0 + ((idx) & 3) * 16 * RQ_STRIDE + ((idx) >> 2) * 64), *(const LAS s16x4*)(qa0 + ((idx) & 3) * 16 * RQ_STRIDE + ((idx) >> 2) * 64 + 32))
                bf16x8 qn0 = RET_QF(0), qn1 = RET_QF(1), qn2 = RET_QF(2);
#pragma unroll
                for (int T = 0; T < 8; ++T) {
                    const bf16x8 bfrag = pack8(S[2 * T], S[2 * T + 1]);
#pragma unroll
                    for (int ib = 0; ib < 4; ++ib) {
                        const int idx = T * 4 + ib; const bf16x8 a = qn0; qn0 = qn1; qn1 = qn2;
                        if (idx + 3 < 32) qn2 = RET_QF(idx + 3);
                        oacc[ib] = __builtin_amdgcn_mfma_f32_16x16x32_bf16(a, bfrag, oacc[ib], 0, 0, 0);
                        __builtin_amdgcn_sched_barrier(0);
                    }
                }
#undef RET_QF
            }
            bf16x8 vfrag[2];
#pragma unroll
            for (int ks = 0; ks < 2; ++ks) {
                LAS unsigned char* va = Vs + (32 * ks + 4 * g + tq) * RV_STRIDE + (w * 16 + 4 * tp) * 2;
                vfrag[ks] = cat8(tr_read(va), tr_read(va + 16 * RV_STRIDE));
            }
            {
                LAS unsigned char* ka0 = Ks + (4 * g + tq) * RK_STRIDE + (4 * tp) * 2;
#define RET_KF(idx) cat8(tr_read(ka0 + ((idx) & 1) * 32 * RK_STRIDE + ((idx) >> 1) * 32), tr_read(ka0 + ((idx) & 1) * 32 * RK_STRIDE + ((idx) >> 1) * 32 + 16 * RK_STRIDE))
                bf16x8 kn0 = RET_KF(0), kn1 = RET_KF(1), kn2 = RET_KF(2);
#pragma unroll
                for (int dkb = 0; dkb < 16; ++dkb) {
#pragma unroll
                    for (int ks = 0; ks < 2; ++ks) {
                        const int idx = dkb * 2 + ks; const bf16x8 a = kn0; kn0 = kn1; kn1 = kn2;
                        if (idx + 3 < 32) kn2 = RET_KF(idx + 3);
                        S[dkb] = __builtin_amdgcn_mfma_f32_16x16x32_bf16(a, vfrag[ks], S[dkb], 0, 0, 0);
                        __builtin_amdgcn_sched_barrier(0);
                    }
                    S[dkb] = S[dkb] * cdec;
                }
#undef RET_KF
            }
            __syncthreads();
#pragma unroll
            for (int ib = 0; ib < 4; ++ib)
#pragma unroll
                for (int ks = 0; ks < 2; ++ks) {
                    const LAS unsigned char* pa = Ps + (ib * 16 + li) * RP_STRIDE + (32 * ks + 4 * g) * 2;
                    const bf16x8 a = cat8(*(const LAS s16x4*)pa, *(const LAS s16x4*)(pa + 32));
                    oacc[ib] = __builtin_amdgcn_mfma_f32_16x16x32_bf16(a, vfrag[ks], oacc[ib], 0, 0, 0);
                }
            {
                bf16_t* ob = OFB + ((size_t)dir * MT + rowbase) * EB + h * 512 + slice * 128 + w * 16 + li;
#pragma unroll
                for (int ib = 0; ib < 4; ++ib)
#pragma unroll
                    for (int r = 0; r < 4; ++r) { const unsigned pk2 = cvt_pk_bf16(oacc[ib][r], 0.f); ob[(size_t)(ib * 16 + 4 * g + r) * EB] = (bf16_t)(pk2 & 0xffffu); }
            }
        }
#undef RET_LOAD
#undef RET_ROWBASE
    }
}
__device__ __forceinline__ void ret_phaseB(const Params& p) {
    unsigned char* ws_ = opq(p.ws);
    const int tid = opaque_tid(), lane = tid & 63, wave = tid >> 6;
    const int gw = blockIdx.x * 8 + wave, NGW = gridDim.x * 8;
    const bf16_t* PROJ = (const bf16_t*)(ws_ + WS_PROJ);
    const bf16_t* OFB = (const bf16_t*)(ws_ + WS_OFB);
    bf16_t* GATED = (bf16_t*)(ws_ + WS_GATED);
    for (int it0 = gw * 4; it0 < MT * 8; it0 += NGW * 4) {
        u32x4 of[4], ob[4], gg[4];
#pragma unroll
        for (int q = 0; q < 4; ++q) { const int item = it0 + q; const int m = item >> 3, h = item & 7; const size_t off = (size_t)m * EB + h * 512 + lane * 8;
            of[q] = *(const u32x4*)(OFB + off); ob[q] = *(const u32x4*)(OFB + (size_t)MT * EB + off); gg[q] = *(const u32x4*)(PROJ + (size_t)m * NP_RET + 8192 + h * 512 + lane * 8); }
#pragma unroll
        for (int q = 0; q < 4; ++q) { const int item = it0 + q; const int m = item >> 3, h = item & 7; const size_t off = (size_t)m * EB + h * 512 + lane * 8;
            float o[8]; float ss = 0.f;
#pragma unroll
            for (int e = 0; e < 4; ++e) { o[2 * e] = bf_lo(of[q][e]) + bf_lo(ob[q][e]); o[2 * e + 1] = bf_hi(of[q][e]) + bf_hi(ob[q][e]); ss += o[2 * e] * o[2 * e] + o[2 * e + 1] * o[2 * e + 1]; }
            ss = wave_sum(ss);
            const float rn = 1.0f / sqrtf(ss * (1.0f / 512.0f) + EPS);
            u32x4 r;
#pragma unroll
            for (int e = 0; e < 4; ++e) { const float g0 = bf_lo(gg[q][e]), g1 = bf_hi(gg[q][e]); r[e] = cvt_pk_bf16(silu_f(g0) * o[2 * e] * rn, silu_f(g1) * o[2 * e + 1] * rn); }
            *(u32x4*)(GATED + off) = r; }
    }
}

constexpr int NA_KSTR = 272, NA_VSTR = 288, NA_VOFF = 17408, NA_BUF = 35840, NA_RPB = 71680, NA_QOFF = 73728, NA_QW = 8704;
constexpr float LOG2E = 1.4426950408889634f;
struct NaQ { f32x4 o[8]; float m, l, pend; };
__device__ __forceinline__ bf16x8 na_softmax(const f32x4 s0, const f32x4 s1, NaQ& q, const bool first) {
    const float x = fmaxf(fmaxf(fmaxf(s0[0], s0[1]), fmaxf(s0[2], s0[3])), fmaxf(fmaxf(s1[0], s1[1]), fmaxf(s1[2], s1[3])));
    const float xa = __shfl_xor(x, 16), xb = __shfl_xor(x, 32), xc = __shfl_xor(x, 48);
    if (first) { const float tmax = fmaxf(fmaxf(x, xa), fmaxf(xb, xc)); q.m = tmax; q.pend = tmax; }
    else {
        const bool need = q.pend > q.m + 8.0f;
        if (__builtin_amdgcn_ballot_w64(need) != 0ull) {
            const float mnew = need ? q.pend : q.m; const float alpha = __builtin_amdgcn_exp2f(q.m - mnew);
#pragma unroll
            for (int db = 0; db < 8; ++db) q.o[db] = q.o[db] * alpha;
            q.l *= alpha; q.m = mnew;
        }
    }
    f32x4 p0, p1;
#pragma unroll
    for (int rr = 0; rr < 4; ++rr) { p0[rr] = __builtin_amdgcn_exp2f(s0[rr] - q.m); p1[rr] = __builtin_amdgcn_exp2f(s1[rr] - q.m); }
    q.l += ((p0[0] + p0[1]) + (p0[2] + p0[3])) + ((p1[0] + p1[1]) + (p1[2] + p1[3]));
    const bf16x8 pf = pack8(p0, p1);
    if (!first) q.pend = fmaxf(q.pend, fmaxf(fmaxf(x, xa), fmaxf(xb, xc)));
    return pf;
}
__device__ __forceinline__ void na_group2(const bool f0, const bool f1, const LAS unsigned char* Qw, LAS unsigned char* Kb, LAS unsigned char* Vb, int cb, bool local, int rb0, const LAS float* rpbs, float sc2,
                                          unsigned vmask, int cbase, NaQ& q0, NaQ& q1, int li, int g, int tq, int tp) {
    f32x4 s00 = (f32x4){0.f, 0.f, 0.f, 0.f}, s01 = s00, s10 = s00, s11 = s00;
#pragma unroll
    for (int kk = 0; kk < 4; ++kk) {
        const bf16x8 ka = *(const LAS bf16x8*)(Kb + (cb + li) * NA_KSTR + (kk * 32 + 8 * g) * 2);
        const bf16x8 kb = *(const LAS bf16x8*)(Kb + (cb + 16 + li) * NA_KSTR + (kk * 32 + 8 * g) * 2);
        const bf16x8 qa = *(const LAS bf16x8*)(Qw + li * NA_KSTR + (kk * 32 + 8 * g) * 2);
        const bf16x8 qb2 = *(const LAS bf16x8*)(Qw + (16 + li) * NA_KSTR + (kk * 32 + 8 * g) * 2);
        s00 = __builtin_amdgcn_mfma_f32_16x16x32_bf16(ka, qa, s00, 0, 0, 0); s01 = __builtin_amdgcn_mfma_f32_16x16x32_bf16(kb, qa, s01, 0, 0, 0);
        s10 = __builtin_amdgcn_mfma_f32_16x16x32_bf16(ka, qb2, s10, 0, 0, 0); s11 = __builtin_amdgcn_mfma_f32_16x16x32_bf16(kb, qb2, s11, 0, 0, 0);
    }
    s00 = s00 * sc2; s01 = s01 * sc2; s10 = s10 * sc2; s11 = s11 * sc2;
    if (local) { const int rb1 = rb0 - 31;
#pragma unroll
        for (int k = 0; k < 4; ++k) { const bool v0 = (vmask >> k) & 1u, v1 = (vmask >> (k + 4)) & 1u;
            const int c0 = min(max(cbase + k, 0), 30), c1 = min(max(cbase + 16 + k, 0), 30);
            float b00 = rpbs[rb0 + c0], b01 = rpbs[rb0 + c1], b10 = rpbs[rb1 + c0], b11 = rpbs[rb1 + c1];
            asm volatile("" : "+v"(b00), "+v"(b01), "+v"(b10), "+v"(b11));
            s00[k] = v0 ? s00[k] + b00 : -INFINITY; s01[k] = v1 ? s01[k] + b01 : -INFINITY;
            s10[k] = v0 ? s10[k] + b10 : -INFINITY; s11[k] = v1 ? s11[k] + b11 : -INFINITY; } }
    const bf16x8 pf0 = na_softmax(s00, s01, q0, f0);
    const bf16x8 pf1 = na_softmax(s10, s11, q1, f1);
    LAS unsigned char* va0 = Vb + (cb + 4 * g + tq) * NA_VSTR + (4 * tp) * 2;
    bf16x8 an0 = cat8(tr_read(va0), tr_read(va0 + 16 * NA_VSTR));
    bf16x8 an1 = cat8(tr_read(va0 + 32), tr_read(va0 + 32 + 16 * NA_VSTR));
    bf16x8 an2 = cat8(tr_read(va0 + 64), tr_read(va0 + 64 + 16 * NA_VSTR));
#pragma unroll
    for (int db = 0; db < 8; ++db) {
        const bf16x8 a = an0; an0 = an1; an1 = an2;
        if (db + 3 < 8) { LAS unsigned char* va = va0 + (db + 3) * 32; an2 = cat8(tr_read(va), tr_read(va + 16 * NA_VSTR)); }
        q0.o[db] = __builtin_amdgcn_mfma_f32_16x16x32_bf16(a, pf0, q0.o[db], 0, 0, 0);
        q1.o[db] = __builtin_amdgcn_mfma_f32_16x16x32_bf16(a, pf1, q1.o[db], 0, 0, 0);
        __builtin_amdgcn_sched_barrier(0);
    }
}
__device__ __forceinline__ void na_group1(const bool f, const LAS unsigned char* Qw, LAS unsigned char* Kb, LAS unsigned char* Vb, int cb, int rb, const LAS float* rpbs, float sc2,
                                          unsigned vmask, int cbase, NaQ& q, int li, int g, int tq, int tp) {
    f32x4 s0 = (f32x4){0.f, 0.f, 0.f, 0.f}, s1 = s0;
#pragma unroll
    for (int kk = 0; kk < 4; ++kk) {
        const bf16x8 ka = *(const LAS bf16x8*)(Kb + (cb + li) * NA_KSTR + (kk * 32 + 8 * g) * 2);
        const bf16x8 kb = *(const LAS bf16x8*)(Kb + (cb + 16 + li) * NA_KSTR + (kk * 32 + 8 * g) * 2);
        const bf16x8 qa = *(const LAS bf16x8*)(Qw + li * NA_KSTR + (kk * 32 + 8 * g) * 2);
        s0 = __builtin_amdgcn_mfma_f32_16x16x32_bf16(ka, qa, s0, 0, 0, 0); s1 = __builtin_amdgcn_mfma_f32_16x16x32_bf16(kb, qa, s1, 0, 0, 0);
    }
    s0 = s0 * sc2; s1 = s1 * sc2;
#pragma unroll
    for (int k = 0; k < 4; ++k) { const bool v0 = (vmask >> k) & 1u, v1 = (vmask >> (k + 4)) & 1u;
        const int c0 = min(max(cbase + k, 0), 30), c1 = min(max(cbase + 16 + k, 0), 30);
        float b0 = rpbs[rb + c0], b1 = rpbs[rb + c1]; asm volatile("" : "+v"(b0), "+v"(b1));
        s0[k] = v0 ? s0[k] + b0 : -INFINITY; s1[k] = v1 ? s1[k] + b1 : -INFINITY; }
    const bf16x8 pf = na_softmax(s0, s1, q, f);
    LAS unsigned char* va0 = Vb + (cb + 4 * g + tq) * NA_VSTR + (4 * tp) * 2;
    bf16x8 an0 = cat8(tr_read(va0), tr_read(va0 + 16 * NA_VSTR));
    bf16x8 an1 = cat8(tr_read(va0 + 32), tr_read(va0 + 32 + 16 * NA_VSTR));
#pragma unroll
    for (int db = 0; db < 8; ++db) {
        const bf16x8 a = an0; an0 = an1;
        if (db + 2 < 8) { LAS unsigned char* va = va0 + (db + 2) * 32; an1 = cat8(tr_read(va), tr_read(va + 16 * NA_VSTR)); }
        q.o[db] = __builtin_amdgcn_mfma_f32_16x16x32_bf16(a, pf, q.o[db], 0, 0, 0);
        __builtin_amdgcn_sched_barrier(0);
    }
}
__device__ __forceinline__ void na_phase(const Params& p, int j, bool with_ctx, LAS unsigned char* lds) {
    unsigned char* ws_ = opq(p.ws);
    const int tid = opaque_tid(), lane = tid & 63, w = __builtin_amdgcn_readfirstlane(tid >> 6), g = lane >> 4, li = lane & 15;
    const int tq = li >> 2, tp = li & 3;
    const bf16_t* PROJ = (const bf16_t*)(ws_ + WS_PROJ);
    bf16_t* GATED = (bf16_t*)(ws_ + WS_GATED);
    LAS float* rpbs = (LAS float*)(lds + NA_RPB);
    const float sc2 = 0.08838834764831845f * LOG2E;
    const int NU = 1024 + (with_ctx ? 128 : 0);
    for (int u = blockIdx.x; u < NU; u += gridDim.x) {
        const bool isctx = u >= 1024;
        int b, head, qb = 0, r0 = 0, rs0 = 0, nloc = 0, qrow0, qrow1, rsw0 = 0, rsw1 = 0;
        if (!isctx) {
            const int rnd = u / (int)gridDim.x, bx = u - rnd * (int)gridDim.x; const int grp = (gridDim.x == 256) ? rnd * 32 + (bx & 7) * 4 + (bx >> 6) : (u >> 3);
            const int rq = (gridDim.x == 256) ? ((bx >> 3) & 7) : (u & 7); b = grp >> 5; head = grp & 31; qb = w & 3; r0 = 4 * rq + 2 * (w >> 2);
            qrow0 = b * SEQ + r0 * 64 + qb * 16; qrow1 = qrow0 + 64; rsw0 = min(max(r0 - 4, 0), 24); rsw1 = min(max(r0 - 3, 0), 24);
            rs0 = min(max(4 * rq - 4, 0), 24); nloc = min(max(4 * rq - 1, 0), 24) + 8 - rs0; }
        else { const int v = u - 1024; b = v >> 5; head = v & 31; qrow0 = ML + b * CTXL + w * 16; qrow1 = qrow0 + 128; }
        const int nit = nloc + 4;
        const int cb_loc = (qb == 0) ? 0 : (qb == 1) ? 8 : (qb == 2) ? 24 : 32;
        if (tid < 465) rpbs[tid] = opq(p.na_rpb)[(size_t)(j * 32 + head) * 465 + tid] * LOG2E;
        unsigned vmask = 0; const int cbase = cb_loc + 4 * g - (qb * 16 + li) + 15;
        { const int qc = qb * 16 + li; const int wsx = min(max(qc - 8, 0), 48);
#pragma unroll
          for (int k = 0; k < 8; ++k) { const int kc = cb_loc + (k >> 2) * 16 + 4 * g + (k & 3); vmask |= ((kc >= wsx) && (kc < wsx + 16)) ? (1u << k) : 0u; } }
        NaQ q0, q1;
        LAS unsigned char* Qw = lds + NA_QOFF + w * NA_QW;
#pragma unroll
        for (int db = 0; db < 8; ++db) { q0.o[db] = (f32x4){0.f, 0.f, 0.f, 0.f}; q1.o[db] = (f32x4){0.f, 0.f, 0.f, 0.f}; }
        q0.m = 0.f; q1.m = 0.f; q0.l = 0.f; q1.l = 0.f; q0.pend = 0.f; q1.pend = 0.f;
        u32x4 pA[2][2];
#define NA_LOAD(it, R) do { const int trow_ = ((it) < nloc) ? b * SEQ + (rs0 + (it)) * 64 : ML + b * CTXL + ((it) - nloc) * 64; _Pragma("unroll") for (int t = 0; t < 2; ++t) { const int idx = tid + 512 * t; \
        const bf16_t* sp = PROJ + (size_t)(trow_ + (idx >> 4)) * NP_NA + 4096 + head * 128 + (idx & 15) * 8; R[t][0] = *(const u32x4*)sp; R[t][1] = *(const u32x4*)(sp + 4096); } } while (0)
#define NA_STORE(buf, R) do { _Pragma("unroll") for (int t = 0; t < 2; ++t) { const int idx = tid + 512 * t; LAS unsigned char* dp = lds + (buf) * NA_BUF; \
        *(LAS u32x4*)(dp + (idx >> 4) * NA_KSTR + (idx & 15) * 16) = R[t][0]; *(LAS u32x4*)(dp + NA_VOFF + (idx >> 4) * NA_VSTR + (idx & 15) * 16) = R[t][1]; } } while (0)
        {
            u32x4 qv[8];
#pragma unroll
            for (int i = 0; i < 8; ++i) { const int c = lane + 64 * i, row = c >> 4, ch = c & 15;
                qv[i] = *(const u32x4*)(PROJ + (size_t)((row < 16 ? qrow0 : qrow1) + (row & 15)) * NP_NA + head * 128 + ch * 8); }
            NA_LOAD(0, pA);
#pragma unroll
            for (int i = 0; i < 8; ++i) { const int c = lane + 64 * i, row = c >> 4, ch = c & 15; *(LAS u32x4*)(Qw + row * NA_KSTR + ch * 16) = qv[i]; }
            NA_STORE(0, pA);
        }
        __syncthreads();
        for (int it = 0; it < nit; ++it) {
            const int cur = it & 1;
            if (it + 1 < nit) NA_LOAD(it + 1, pA);
            const bool local = it < nloc; const int kr = rs0 + it;
            LAS unsigned char* Kb = lds + cur * NA_BUF; LAS unsigned char* Vb = Kb + NA_VOFF;
            if (local) {
                const bool act0 = (kr >= rsw0 && kr < rsw0 + 8), act1 = (kr >= rsw1 && kr < rsw1 + 8); const int rb0 = (kr - r0 + 7) * 31;
                if (act0 && act1) na_group2(kr == rsw0, kr == rsw1, Qw, Kb, Vb, cb_loc, true, rb0, rpbs, sc2, vmask, cbase, q0, q1, li, g, tq, tp);
                else if (act0) na_group1(kr == rsw0, Qw, Kb, Vb, cb_loc, rb0, rpbs, sc2, vmask, cbase, q0, li, g, tq, tp);
                else if (act1) na_group1(kr == rsw1, Qw + 16 * NA_KSTR, Kb, Vb, cb_loc, rb0 - 31, rpbs, sc2, vmask, cbase, q1, li, g, tq, tp);
            } else {
                const bool f_ = isctx && it == 0;
                for (int gi = 0; gi < 2; ++gi) na_group2(f_ && gi == 0, f_ && gi == 0, Qw, Kb, Vb, gi * 32, false, 0, rpbs, sc2, vmask, cbase, q0, q1, li, g, tq, tp);
            }
            if (it + 1 < nit) NA_STORE(cur ^ 1, pA);
            __syncthreads();
        }
#undef NA_LOAD
#undef NA_STORE
#pragma unroll
        for (int t = 0; t < 2; ++t) {
            float lt = t ? q1.l : q0.l; lt += __shfl_xor(lt, 16); lt += __shfl_xor(lt, 32);
            const float inv = 1.0f / lt; const size_t row = (size_t)((t ? qrow1 : qrow0) + li);
#pragma unroll
            for (int db = 0; db < 8; ++db) { const int d = db * 16 + 4 * g; const f32x4 ov = t ? q1.o[db] : q0.o[db];
                const u32x2 gg = *(const u32x2*)(PROJ + row * NP_NA + 12288 + head * 128 + d);
                u32x2 wv; wv.x = cvt_pk_bf16(ov[0] * inv * silu_f(bf_lo(gg.x)), ov[1] * inv * silu_f(bf_hi(gg.x)));
                wv.y = cvt_pk_bf16(ov[2] * inv * silu_f(bf_lo(gg.y)), ov[3] * inv * silu_f(bf_hi(gg.y)));
                *(u32x2*)(GATED + row * EB + head * 128 + d) = wv; }
        }
    }
}

#define XB_TMO      128
#define XB_XCNT(j)  (256  + 64 * (j))
#define XB_XSUB(j)  (1280 + 64 * (j))
#define XB_XGEN(j)  (2304 + 64 * (j))
#define XB_TOP      3328
#define XB_TOPGEN   3392
#define XCD_BAR_WORDS 3456
#define XB_SPIN_CAP (1u << 20)
__device__ __forceinline__ unsigned xb_ld(unsigned* p)              { return __hip_atomic_load(p, __ATOMIC_RELAXED, __HIP_MEMORY_SCOPE_AGENT); }
__device__ __forceinline__ unsigned xb_add(unsigned* p, unsigned v) { return __hip_atomic_fetch_add(p, v, __ATOMIC_RELAXED, __HIP_MEMORY_SCOPE_AGENT); }
__device__ __forceinline__ unsigned xb_xcc_id() { return (unsigned)__builtin_amdgcn_s_getreg((3 << 11) | 20) & 0xFu; }
#define XB_SPIN(cond, bar) do { unsigned _sp = 0; while (cond) { __builtin_amdgcn_s_sleep(1); \
    if ((++_sp & 255u) == 0u) { if (xb_ld(&(bar)[XB_TMO])) break; if (_sp > XB_SPIN_CAP) { atomicAdd(&(bar)[XB_TMO], 1u); break; } } } } while (0)
struct XcdBarrier { unsigned* bar; unsigned x; volatile LAS unsigned* st; };
__device__ __forceinline__ XcdBarrier xcd_barrier_post(unsigned* bar, volatile LAS unsigned* st) {
    XcdBarrier b; b.bar = bar; b.x = xb_xcc_id(); b.st = st;
    if (threadIdx.x == 0) (void)xb_add(&bar[XB_XCNT(b.x)], 1u);
    return b;
}
__device__ __forceinline__ void xcd_barrier_complete(unsigned* bar, unsigned x, unsigned& nloc, unsigned& nx) {
    const unsigned G = gridDim.x * gridDim.y * gridDim.z;
    unsigned sum, cnt, mine, sp = 0u;
    for (;;) {
        sum = 0u; cnt = 0u; mine = 0u;
#pragma unroll
        for (unsigned j = 0; j < 16; ++j) { const unsigned c = xb_ld(&bar[XB_XCNT(j)]); sum += c; cnt += (c > 0u) ? 1u : 0u; mine = (j == x) ? c : mine; }
        if (sum == G) break;
        __builtin_amdgcn_s_sleep(1);
        if ((++sp & 255u) == 0u) { if (xb_ld(&bar[XB_TMO])) break; if (sp > XB_SPIN_CAP) { atomicAdd(&bar[XB_TMO], 1u); break; } }
    }
    nloc = mine > 0u ? mine : 1u; nx = cnt > 0u ? cnt : 1u;
}
__device__ __forceinline__ void xcd_barrier(const XcdBarrier& b) {
    asm volatile("s_waitcnt vmcnt(0)" ::: "memory");
    __syncthreads();
    if (threadIdx.x == 0) {
        unsigned* bar = b.bar;
        __builtin_amdgcn_s_waitcnt(0);
        unsigned nloc = b.st[0], nx = b.st[1];
        if (nloc == 0u) { xcd_barrier_complete(bar, b.x, nloc, nx); b.st[0] = nloc; b.st[1] = nx; }
        const unsigned old = xb_add(&bar[XB_XSUB(b.x)], 1u);
        const unsigned gen = old / nloc;
        if (old + 1u == (gen + 1u) * nloc) {
            __builtin_amdgcn_fence(__ATOMIC_RELEASE, "agent");
            asm volatile("s_waitcnt vmcnt(0)" ::: "memory");
            const unsigned og = xb_add(&bar[XB_TOP], 1u);
            const unsigned tg = og / nx;
            if (og + 1u == (tg + 1u) * nx) xb_add(&bar[XB_TOPGEN], 1u);
            else XB_SPIN(xb_ld(&bar[XB_TOPGEN]) == tg, bar);
            __builtin_amdgcn_fence(__ATOMIC_ACQUIRE, "agent");
            xb_add(&bar[XB_XGEN(b.x)], 1u);
            asm volatile("s_waitcnt vmcnt(0)" ::: "memory");
        } else {
            XB_SPIN(xb_ld(&bar[XB_XGEN(b.x)]) == gen, bar);
            __builtin_amdgcn_fence(__ATOMIC_ACQUIRE, "agent");
            asm volatile("s_waitcnt vmcnt(0)" ::: "memory");
        }
    }
    __syncthreads();
}

__global__ void __launch_bounds__(512, 2) fwd_megakernel(Params p) {
    extern __shared__ __attribute__((aligned(16))) unsigned char smem[];
    LAS unsigned char* lds = (LAS unsigned char*)smem;
    cg::grid_group grid = cg::this_grid();
    unsigned* barw = (unsigned*)(opq(p.ws) + WS_BAR);
    volatile LAS unsigned* bst = (volatile LAS unsigned*)(lds + LDS_BYTES - 64);
    if (blockIdx.x == 0) for (int i = threadIdx.x; i < XCD_BAR_WORDS; i += 512) barw[i] = 0u;
    if (threadIdx.x < 2) bst[threadIdx.x] = 0u;
#ifndef NO_PRO
    prologue(p, lds);
#endif
    grid.sync();
    const XcdBarrier xbar = xcd_barrier_post(barw, bst);
#define GSYNC() xcd_barrier(xbar)
    const bf16_t* H = (const bf16_t*)(opq(p.ws) + WS_H);
    bf16_t* PROJ = (bf16_t*)(opq(p.ws) + WS_PROJ);
    const bf16_t* GATED = (const bf16_t*)(opq(p.ws) + WS_GATED);
    float* XS = (float*)(opq(p.ws) + WS_XS);
    for (int l = 0; l < 4; ++l) {
        const int j = l >> 1; const bool isna = (l & 1) != 0;
        norm_phase(p, l);
        GSYNC();
        {
            const int N = isna ? NP_NA : NP_RET;
            const bf16_t* Bt = (const bf16_t*)(opq(p.ws) + (isna ? (j ? WS_WNI1 : WS_WNI0) : (j ? WS_WRI1 : WS_WRI0)));
            pg8::Gemm gm{H, Bt, MT, N, DM, DM}; pg8::StaticOrder S; S.init(MT, N, (int)gridDim.x, (int)blockIdx.x);
            pg8::EpiBf16 E{PROJ, N};
#ifndef NO_G1
            pg8::gemm_phase<pg8::EpiBf16, pg8::StaticOrder>(lds, gm, S, E);
#endif
        }
        GSYNC();
#ifndef NO_RETA
        if (!isna) { ret_phaseA(p, j, lds); GSYNC(); ret_phaseB(p); }
#endif
#ifndef NO_NA
        if (isna) na_phase(p, j, l != 3, lds);
#endif
        GSYNC();
        {
            const bf16_t* Bt = (const bf16_t*)(opq(p.ws) + (isna ? (j ? WS_WNO1 : WS_WNO0) : (j ? WS_WRO1 : WS_WRO0)));
            {
                pg8::Gemm gm{GATED, Bt, ML, DM, EB, EB}; pg8::StaticOrder S; S.init(ML, DM, (int)gridDim.x, (int)blockIdx.x);
                pg8::EpiResid E{(l == 0) ? (const float*)opq(p.x) : (const float*)XS, XS, (const float*)(opq(p.ws) + WS_MODV) + (size_t)l * 5 * 6144 + 4096};
                pg8::gemm_phase<pg8::EpiResid, pg8::StaticOrder>(lds, gm, S, E);
            }
            if (l != 3) {
                pg8::Gemm gm{GATED + (size_t)ML * EB, Bt, MC, DM, EB / 8, EB}; pg8::SplitOrder S; S.init(MC, DM, 8, (int)gridDim.x, (int)blockIdx.x);
                pg8::EpiPartial E{(float*)(opq(p.ws) + WS_PART), MC, DM};
                pg8::gemm_phase<pg8::EpiPartial, pg8::SplitOrder>(lds, gm, S, E);
            }
        }
        GSYNC();
    }
    final_norm(p);
}

extern "C" void kernel_launch(void* const* d_in, const int* in_sizes, int n_in, void* d_out, int out_size, void* d_ws, size_t ws_size, hipStream_t stream) {
    static int grid_blocks = 0;
    if (grid_blocks == 0) {
        if (ws_size < WS_END) { fprintf(stderr, "kernel_launch: workspace too small (%zu < %zu)\n", ws_size, (size_t)WS_END); grid_blocks = -1; return; }
        int dev = 0, cus = 0, per_cu = 0;
        hipGetDevice(&dev);
        hipDeviceGetAttribute(&cus, hipDeviceAttributeMultiprocessorCount, dev);
        if (hipFuncSetAttribute((const void*)fwd_megakernel, hipFuncAttributeMaxDynamicSharedMemorySize, LDS_BYTES) != hipSuccess) { fprintf(stderr, "kernel_launch: hipFuncSetAttribute failed\n"); }
        if (hipOccupancyMaxActiveBlocksPerMultiprocessor(&per_cu, (const void*)fwd_megakernel, 512, LDS_BYTES) != hipSuccess || per_cu < 1) { fprintf(stderr, "kernel_launch: occupancy query says %d\n", per_cu); per_cu = 1; }
        (void)hipGetLastError();
        grid_blocks = cus * 1;
        if (grid_blocks <= 0) grid_blocks = 256;
    }
    if (grid_blocks < 0) return;
    Params p{};
    p.x = (const float*)d_in[0]; p.c = (const float*)d_in[1]; p.ctx = (const float*)d_in[2]; p.c_ctx = (const float*)d_in[3];
    p.mod_w = (const float*)d_in[4]; p.mod_b = (const float*)d_in[5]; p.norm_g = (const float*)d_in[6]; p.ret_w_in = (const float*)d_in[7];
    p.ret_df = (const float*)d_in[8]; p.ret_db = (const float*)d_in[9]; p.ret_w_out = (const float*)d_in[10]; p.na_w_in = (const float*)d_in[11];
    p.na_rpb = (const float*)d_in[12]; p.na_w_out = (const float*)d_in[13]; p.final_g = (const float*)d_in[14];
    p.out = (float*)d_out; p.ws = (unsigned char*)d_ws;
    void* args[] = {&p};
    hipError_t e = hipLaunchCooperativeKernel((const void*)fwd_megakernel, dim3(grid_blocks), dim3(512), args, LDS_BYTES, stream);
    if (e != hipSuccess) fprintf(stderr, "cooperative launch failed: %s (grid %d)\n", hipGetErrorString(e), grid_blocks);
}
```

```cpp
#include <hip/hip_runtime.h>
#include <hip/hip_cooperative_groups.h>
#include <cstdio>
namespace cg = cooperative_groups;

#define LAS __attribute__((address_space(3)))
typedef unsigned short bf16_t;
typedef short bf16x8 __attribute__((ext_vector_type(8)));
typedef short s16x4 __attribute__((ext_vector_type(4)));
typedef float f32x4 __attribute__((ext_vector_type(4)));
typedef float f32x2 __attribute__((ext_vector_type(2)));
typedef unsigned u32x4 __attribute__((ext_vector_type(4)));
typedef unsigned u32x2 __attribute__((ext_vector_type(2)));

constexpr int DM = 2048, NB = 4, SEQ = 2048, CTXL = 256, EB = 4096;
constexpr int ML = NB * SEQ, MC = NB * CTXL, MT = ML + MC;
constexpr int NP_RET = 12288, NP_NA = 16384;
constexpr float EPS = 1e-6f;

constexpr size_t MiB = 1u << 20;
constexpr size_t WS_WRI0 = 0, WS_WRI1 = 48 * MiB, WS_WNI0 = 96 * MiB, WS_WNI1 = 160 * MiB;
constexpr size_t WS_WRO0 = 224 * MiB, WS_WRO1 = 240 * MiB, WS_WNO0 = 256 * MiB, WS_WNO1 = 272 * MiB;
constexpr size_t WS_MODV = 288 * MiB, WS_ROPE = 289 * MiB, WS_XS = 290 * MiB, WS_H = 362 * MiB;
constexpr size_t WS_PROJ = 398 * MiB, WS_GATED = 686 * MiB, WS_OFB = 758 * MiB, WS_PART = 902 * MiB, WS_BAR = 966 * MiB, WS_END = 967 * MiB;

constexpr int LDS_BYTES = 147456;

struct Params {
    const float *x, *c, *ctx, *c_ctx, *mod_w, *mod_b, *norm_g, *ret_w_in, *ret_df, *ret_db, *ret_w_out, *na_w_in, *na_rpb, *na_w_out, *final_g;
    float* out; unsigned char* ws;
};

__device__ __forceinline__ unsigned cvt_pk_bf16(float lo, float hi) { unsigned r; asm volatile("v_cvt_pk_bf16_f32 %0, %1, %2" : "=v"(r) : "v"(lo), "v"(hi)); return r; }
__device__ __forceinline__ float bf_lo(unsigned u) { return __uint_as_float(u << 16); }
__device__ __forceinline__ float bf_hi(unsigned u) { return __uint_as_float(u & 0xffff0000u); }
__device__ __forceinline__ float wave_sum(float v) {
#define WS_DPP(ctrl) v += __builtin_bit_cast(float, __builtin_amdgcn_update_dpp(0, __builtin_bit_cast(int, v), (ctrl), 0xf, 0xf, false))
    WS_DPP(0x128); WS_DPP(0x124); WS_DPP(0x122); WS_DPP(0x121);
#undef WS_DPP
    const int vi = __builtin_bit_cast(int, v);
    const float r0 = __builtin_bit_cast(float, __builtin_amdgcn_readlane(vi, 0)), r1 = __builtin_bit_cast(float, __builtin_amdgcn_readlane(vi, 16));
    const float r2 = __builtin_bit_cast(float, __builtin_amdgcn_readlane(vi, 32)), r3 = __builtin_bit_cast(float, __builtin_amdgcn_readlane(vi, 48));
    return (r0 + r1) + (r2 + r3);
}
__device__ __forceinline__ int opaque_tid() { int t = threadIdx.x; asm volatile("" : "+v"(t)); return t; }
template <class T> __device__ __forceinline__ T* opq(T* q) { __attribute__((address_space(1))) T* g = (__attribute__((address_space(1))) T*)q; asm volatile("" : "+s"(g)); return (T*)g; }
__device__ __forceinline__ float silu_f(float v) { return v / (1.0f + __expf(-v)); }
__device__ __forceinline__ s16x4 tr_read(LAS unsigned char* p) {
    typedef short v4i16_t __attribute__((ext_vector_type(4)));
    return __builtin_bit_cast(s16x4, __builtin_amdgcn_ds_read_tr16_b64_v4i16((LAS v4i16_t*)p));
}
__device__ __forceinline__ bf16x8 cat8(s16x4 lo, s16x4 hi) { const u32x2 a = __builtin_bit_cast(u32x2, lo), b = __builtin_bit_cast(u32x2, hi); u32x4 r; r.x = a.x; r.y = a.y; r.z = b.x; r.w = b.y; return __builtin_bit_cast(bf16x8, r); }
__device__ __forceinline__ bf16x8 pack8(f32x4 a, f32x4 b) {
    u32x4 w; w.x = cvt_pk_bf16(a[0], a[1]); w.y = cvt_pk_bf16(a[2], a[3]); w.z = cvt_pk_bf16(b[0], b[1]); w.w = cvt_pk_bf16(b[2], b[3]);
    return __builtin_bit_cast(bf16x8, w);
}

namespace pg8 {
constexpr int BM = 256, BK = 64, HALF = 128, HTB = HALF * BK * 2, STAGE_BYTES = 8 * HTB, NXCD = 8, WGM = 8;
__host__ __device__ __forceinline__ int lds_byte(int r, int c) { const int st = (r >> 4) * 2 + (c >> 5), rr = r & 15, cc = c & 31, ob = rr * 64 + cc * 2; return st * 1024 + (ob ^ (((ob >> 9) & 1) << 5)); }
__host__ __device__ __forceinline__ void stage_rc(int b, int& R, int& C) { const int st = b / 1024, sb = b % 1024, swz = sb ^ (((sb >> 9) & 1) << 5); R = (st >> 1) * 16 + swz / 64; C = (st & 1) * 32 + (swz % 64) / 2; }
__host__ __device__ __forceinline__ int perm32(int rho) { const int n = rho >> 4, i = rho & 15; return 8 * (i >> 2) + 4 * n + (i & 3); }

struct Unit { int pm, pn, ks; };
struct Gemm { const bf16_t* A; const bf16_t* Bt; int M, N, K, ld; };

struct StaticOrder {
    int nM, nN, nwg, G, c;
    __device__ void init(int M, int N, int G_, int c_) { nM = M / BM; nN = N / BM; nwg = nM * nN; G = G_; c = c_; }
    __device__ bool next(int i, Unit& u) const {
        const long L = (long)i * G + c; if (L >= nwg) return false;
        int wgid = (int)L; { const int q = nwg / NXCD, r = nwg % NXCD, xcd = wgid % NXCD, off = wgid / NXCD; wgid = (xcd < r ? xcd * (q + 1) : r * (q + 1) + (xcd - r) * q) + off; }
        const int nig = WGM * nN, gid = wgid / nig, fm = gid * WGM, gsz = (nM - fm) < WGM ? (nM - fm) : WGM;
        u.pm = fm + ((wgid % nig) % gsz); u.pn = (wgid % nig) / gsz; u.ks = 0; return true;
    }
    __device__ __forceinline__ void a_ready(const Unit&) const {}
    __device__ __forceinline__ void done(const Unit&) const {}
};

struct SplitOrder {
    int nM, nN, nS, nwg, G, c;
    __device__ void init(int M, int N, int nS_, int G_, int c_) { nM = M / BM; nN = N / BM; nS = nS_; nwg = nM * nN * nS; G = G_; c = c_; }
    __device__ bool next(int i, Unit& u) const {
        const long L = (long)i * G + c; if (L >= nwg) return false;
        const int l = (int)L; u.ks = l % nS; const int t = l / nS; u.pm = t % nM; u.pn = t / nM; return true;
    }
    __device__ __forceinline__ void a_ready(const Unit&) const {}
    __device__ __forceinline__ void done(const Unit&) const {}
};
struct EpiPartial {
    static constexpr bool PERM = false;
    float* P; int rows, ldc;
    __device__ __forceinline__ void operator()(const f32x4 (&acc)[2][2][4][2], const Unit& u, int wr, int wc, int fr, int fq) const {
        const int row0 = u.pm * BM + wr * 64 + fr, col0 = u.pn * BM + wc * 32 + 4 * fq;
        float* base = P + (size_t)u.ks * rows * ldc;
#pragma unroll
        for (int ai = 0; ai < 2; ++ai)
#pragma unroll
            for (int m = 0; m < 4; ++m) { float* rowp = base + (size_t)(row0 + ai * HALF + m * 16) * ldc + col0;
#pragma unroll
                for (int bj = 0; bj < 2; ++bj)
#pragma unroll
                    for (int n = 0; n < 2; ++n) *(f32x4*)(rowp + bj * HALF + n * 16) = acc[ai][bj][m][n]; }
    }
};
struct EpiBf16 {
    static constexpr bool PERM = true;
    bf16_t* O; int ldc;
    __device__ __forceinline__ void operator()(const f32x4 (&acc)[2][2][4][2], const Unit& u, int wr, int wc, int fr, int fq) const {
        const int row0 = u.pm * BM + wr * 64 + fr; const int col0 = u.pn * BM + wc * 32 + 8 * fq;
#pragma unroll
        for (int ai = 0; ai < 2; ++ai)
#pragma unroll
            for (int m = 0; m < 4; ++m) { bf16_t* rowp = O + (size_t)(row0 + ai * HALF + m * 16) * ldc + col0;
#pragma unroll
                for (int bj = 0; bj < 2; ++bj) { const f32x4 v0 = acc[ai][bj][m][0], v1 = acc[ai][bj][m][1];
                    u32x4 w; w.x = cvt_pk_bf16(v0[0], v0[1]); w.y = cvt_pk_bf16(v0[2], v0[3]); w.z = cvt_pk_bf16(v1[0], v1[1]); w.w = cvt_pk_bf16(v1[2], v1[3]);
                    *(u32x4*)(rowp + bj * HALF) = w; } }
    }
};
struct EpiResid {
    static constexpr bool PERM = false;
    const float* xsrc; float* xout; const float* gt_base;
    __device__ __forceinline__ void operator()(const f32x4 (&acc)[2][2][4][2], const Unit& u, int wr, int wc, int fr, int fq) const {
        const int row0 = u.pm * BM + wr * 64 + fr, col0 = u.pn * BM + wc * 32 + 4 * fq;
        const int mrow = (u.pm * BM < ML) ? ((u.pm * BM) >> 11) : 4;
        const float* gt = gt_base + mrow * 6144;
        f32x4 gv[2][2];
#pragma unroll
        for (int bj = 0; bj < 2; ++bj)
#pragma unroll
            for (int n = 0; n < 2; ++n) gv[bj][n] = *(const f32x4*)(gt + col0 + bj * HALF + n * 16);
#pragma unroll
        for (int ai = 0; ai < 2; ++ai) {
            f32x4 xv[4][2][2];
#pragma unroll
            for (int m = 0; m < 4; ++m) { const float* sp = xsrc + (size_t)(row0 + ai * HALF + m * 16) * DM;
#pragma unroll
                for (int bj = 0; bj < 2; ++bj)
#pragma unroll
                    for (int n = 0; n < 2; ++n) xv[m][bj][n] = *(const f32x4*)(sp + col0 + bj * HALF + n * 16); }
#pragma unroll
            for (int m = 0; m < 4; ++m) { float* dp = xout + (size_t)(row0 + ai * HALF + m * 16) * DM;
#pragma unroll
                for (int bj = 0; bj < 2; ++bj)
#pragma unroll
                    for (int n = 0; n < 2; ++n) *(f32x4*)(dp + col0 + bj * HALF + n * 16) = xv[m][bj][n] + gv[bj][n] * acc[ai][bj][m][n]; }
        }
    }
};

template <class Epi, class Sched, bool ALIGN_EPI = true, bool SP2 = true>
__device__ __forceinline__ void gemm_phase(LAS unsigned char* lds, const Gemm g, const Sched& S, const Epi& E) {
    const int tid = opaque_tid(), wid = __builtin_amdgcn_readfirstlane(tid >> 6), lane = tid & 63, wr = wid >> 2, wc = wid & 3, fr = lane & 15, fq = lane >> 4;
    const int K = g.ld, nt = g.K / BK;
    unsigned voffA[2], voffB[2];
#pragma unroll
    for (int i = 0; i < 2; ++i) { int R, C; stage_rc(tid * 16 + i * 8192, R, C); const int Rb = Epi::PERM ? ((R & ~31) + perm32(R & 31)) : R;
        voffA[i] = (unsigned)(R * K + C) * 2u; voffB[i] = (unsigned)(Rb * K + C) * 2u; }
    const size_t kstep = (size_t)(BK * 2);
    const size_t hstep = (size_t)HALF * K * 2;
    const size_t tstep = 2 * hstep;
    const unsigned ldsw = (unsigned)wid * 1024u;
    const int aoff = lds_byte(wr * 64 + fr, fq * 8), boff = lds_byte(wc * 32 + fr, fq * 8);
#define PG8_SA(b, h) (((b) * 2 + (h)) * HTB)
#define PG8_SB(b, h) ((4 + (b) * 2 + (h)) * HTB)
#define PG8_STAGE(bufoff, gbase, voff) do { _Pragma("unroll") for (int _i = 0; _i < 2; ++_i) \
        __builtin_amdgcn_global_load_lds((const unsigned*)((const char*)(gbase) + (voff)[_i]), (LAS unsigned*)(lds + (bufoff) + ldsw + _i * 8192), 16, 0, 0); } while (0)
#define PG8_LDA(dst, b, h) do { _Pragma("unroll") for (int m = 0; m < 4; ++m) _Pragma("unroll") for (int k = 0; k < 2; ++k) dst[m][k] = *(const LAS bf16x8*)(lds + PG8_SA(b, h) + aoff + m * 2048 + k * 1024); } while (0)
#define PG8_LDB(dst, b, h) do { _Pragma("unroll") for (int n = 0; n < 2; ++n) _Pragma("unroll") for (int k = 0; k < 2; ++k) dst[n][k] = *(const LAS bf16x8*)(lds + PG8_SB(b, h) + boff + n * 2048 + k * 1024); } while (0)
#define PG8_MMA(ai, bj, At, Bt) do { __builtin_amdgcn_s_setprio(1); _Pragma("unroll") for (int m = 0; m < 4; ++m) _Pragma("unroll") for (int n = 0; n < 2; ++n) _Pragma("unroll") for (int k = 0; k < 2; ++k) \
        acc[ai][bj][m][n] = __builtin_amdgcn_mfma_f32_16x16x32_bf16(Bt[n][k], At[m][k], acc[ai][bj][m][n], 0, 0, 0); __builtin_amdgcn_s_setprio(0); } while (0)
#define PG8_WAIT_V(n) asm volatile("s_waitcnt vmcnt(" #n ")" ::: "memory")
#define PG8_WAIT_L(n) asm volatile("s_waitcnt lgkmcnt(" #n ")" ::: "memory")
#define PG8_BAR __builtin_amdgcn_s_barrier()
#define PG8_SCHED __builtin_amdgcn_sched_barrier(0)
    Unit cur, nxt; int ui = 0;
    if (!S.next(0, cur)) return;
    f32x4 acc[2][2][4][2];
#pragma unroll
    for (int a = 0; a < 2; ++a)
#pragma unroll
        for (int b = 0; b < 2; ++b)
#pragma unroll
            for (int m = 0; m < 4; ++m)
#pragma unroll
                for (int n = 0; n < 2; ++n) acc[a][b][m][n] = (f32x4){0.f, 0.f, 0.f, 0.f};
    bf16x8 At[4][2], B0[2][2], B1[2][2];
    const size_t ksb = (size_t)g.K * 2;
    const char* cA = (const char*)g.A + (size_t)cur.pm * tstep + cur.ks * ksb; const char* cB = (const char*)g.Bt + (size_t)cur.pn * tstep + cur.ks * ksb;
    S.a_ready(cur);
    if constexpr (SP2) {
        PG8_STAGE(PG8_SB(0, 0), cB, voffB); PG8_STAGE(PG8_SB(0, 1), cB + hstep, voffB); PG8_STAGE(PG8_SA(0, 0), cA, voffA); PG8_STAGE(PG8_SA(0, 1), cA + hstep, voffA);
        if (wr == 1) PG8_BAR;
        PG8_WAIT_V(2); PG8_BAR;
        PG8_STAGE(PG8_SB(1, 0), cB + kstep, voffB); PG8_STAGE(PG8_SA(1, 0), cA + kstep, voffA); PG8_STAGE(PG8_SB(1, 1), cB + hstep + kstep, voffB);
        PG8_WAIT_V(6); PG8_BAR;
    } else {
        PG8_STAGE(PG8_SB(0, 0), cB, voffB); PG8_STAGE(PG8_SA(0, 0), cA, voffA); PG8_STAGE(PG8_SB(0, 1), cB + hstep, voffB); PG8_STAGE(PG8_SA(0, 1), cA + hstep, voffA);
        if (wr == 1) PG8_BAR;
        PG8_WAIT_V(4); PG8_BAR;
        PG8_STAGE(PG8_SB(1, 0), cB + kstep, voffB); PG8_STAGE(PG8_SA(1, 0), cA + kstep, voffA); PG8_STAGE(PG8_SB(1, 1), cB + hstep + kstep, voffB);
        PG8_WAIT_V(6); PG8_BAR;
    }
    for (;;) {
        const bool has_next = S.next(ui + 1, nxt);
        const char* nA = has_next ? (const char*)g.A + (size_t)nxt.pm * tstep + nxt.ks * ksb : cA; const char* nB = has_next ? (const char*)g.Bt + (size_t)nxt.pn * tstep + nxt.ks * ksb : cB;
        for (int t = 0; t < nt; t += 2) {
            const bool last = (t == nt - 2);
            const char* a1 = cA + (size_t)(t + 1) * kstep;
            const char* a2 = last ? nA : cA + (size_t)(t + 2) * kstep; const char* b2 = last ? nB : cB + (size_t)(t + 2) * kstep;
            const char* a3 = a2 + kstep; const char* b3 = b2 + kstep;
            if (last && has_next) S.a_ready(nxt);
            if constexpr (SP2) {
            PG8_LDB(B0, 0, 0); PG8_LDB(B1, 0, 1); PG8_SCHED; PG8_LDA(At, 0, 0); PG8_STAGE(PG8_SA(1, 1), a1 + hstep, voffA);
            PG8_WAIT_V(8); PG8_WAIT_L(0); PG8_BAR; PG8_MMA(0, 0, At, B0); PG8_MMA(0, 1, At, B1); PG8_BAR; PG8_SCHED;
            PG8_LDA(At, 0, 1); PG8_STAGE(PG8_SB(0, 0), b2, voffB); PG8_STAGE(PG8_SB(0, 1), b2 + hstep, voffB); PG8_STAGE(PG8_SA(0, 0), a2, voffA);
            PG8_WAIT_V(8); PG8_WAIT_L(0); PG8_BAR; PG8_MMA(1, 0, At, B0); PG8_MMA(1, 1, At, B1); PG8_BAR; PG8_SCHED;
            PG8_LDB(B0, 1, 0); PG8_LDB(B1, 1, 1); PG8_SCHED; PG8_LDA(At, 1, 0); PG8_STAGE(PG8_SA(0, 1), a2 + hstep, voffA);
            PG8_WAIT_V(8); PG8_WAIT_L(0); PG8_BAR; PG8_MMA(0, 0, At, B0); PG8_MMA(0, 1, At, B1); PG8_BAR; PG8_SCHED;
            PG8_LDA(At, 1, 1); PG8_STAGE(PG8_SB(1, 0), b3, voffB); PG8_STAGE(PG8_SB(1, 1), b3 + hstep, voffB); PG8_STAGE(PG8_SA(1, 0), a3, voffA);
            PG8_WAIT_V(8); PG8_WAIT_L(0); PG8_BAR; PG8_MMA(1, 0, At, B0); PG8_MMA(1, 1, At, B1); PG8_BAR; PG8_SCHED;
            } else {
            PG8_LDB(B0, 0, 0); PG8_SCHED; PG8_LDA(At, 0, 0); PG8_STAGE(PG8_SA(1, 1), a1 + hstep, voffA);
            PG8_WAIT_L(8); PG8_BAR; PG8_WAIT_L(0); PG8_MMA(0, 0, At, B0); PG8_BAR; PG8_SCHED;
            PG8_LDB(B1, 0, 1); PG8_STAGE(PG8_SB(0, 0), b2, voffB);
            PG8_BAR; PG8_WAIT_L(0); PG8_MMA(0, 1, At, B1); PG8_BAR;
            PG8_LDA(At, 0, 1); PG8_STAGE(PG8_SA(0, 0), a2, voffA);
            PG8_BAR; PG8_WAIT_L(0); PG8_MMA(1, 0, At, B0); PG8_BAR; PG8_SCHED;
            PG8_STAGE(PG8_SB(0, 1), b2 + hstep, voffB);
            PG8_WAIT_V(6); PG8_BAR; PG8_MMA(1, 1, At, B1); PG8_BAR;
            PG8_LDB(B0, 1, 0); PG8_SCHED; PG8_LDA(At, 1, 0); PG8_STAGE(PG8_SA(0, 1), a2 + hstep, voffA);
            PG8_WAIT_L(8); PG8_BAR; PG8_WAIT_L(0); PG8_MMA(0, 0, At, B0); PG8_BAR; PG8_SCHED;
            PG8_LDB(B1, 1, 1); PG8_STAGE(PG8_SB(1, 0), b3, voffB);
            PG8_BAR; PG8_WAIT_L(0); PG8_MMA(0, 1, At, B1); PG8_BAR;
            PG8_LDA(At, 1, 1); PG8_STAGE(PG8_SA(1, 0), a3, voffA);
            PG8_BAR; PG8_WAIT_L(0); PG8_MMA(1, 0, At, B0); PG8_BAR; PG8_SCHED;
            PG8_STAGE(PG8_SB(1, 1), b3 + hstep, voffB);
            PG8_WAIT_V(6); PG8_BAR; PG8_MMA(1, 1, At, B1); PG8_BAR;
            }
        }
        if constexpr (ALIGN_EPI) { if (wr == 0) PG8_BAR; }
        E(acc, cur, wr, wc, fr, fq); S.done(cur);
        if (!has_next) break;
#pragma unroll
        for (int a = 0; a < 2; ++a)
#pragma unroll
            for (int b = 0; b < 2; ++b)
#pragma unroll
                for (int m = 0; m < 4; ++m)
#pragma unroll
                    for (int n = 0; n < 2; ++n) acc[a][b][m][n] = (f32x4){0.f, 0.f, 0.f, 0.f};
        cur = nxt; cA = nA; cB = nB; ++ui;
        if constexpr (ALIGN_EPI) { if (wr == 1) PG8_BAR; }
    }
    PG8_WAIT_V(0);
    if constexpr (!ALIGN_EPI) { if (wr == 0) PG8_BAR; }
    PG8_BAR;
#undef PG8_SA
#undef PG8_SB
#undef PG8_STAGE
#undef PG8_LDA
#undef PG8_LDB
#undef PG8_MMA
#undef PG8_WAIT_V
#undef PG8_WAIT_L
#undef PG8_BAR
#undef PG8_SCHED
}
}

__device__ __forceinline__ void transpose_item(const float* W, int K, int N, bf16_t* WT, LAS float* scr, int item, int lane) {
    const int nblk = N >> 6, kb = item / nblk, nb = item - kb * nblk, k0 = kb * 64, n0 = nb * 64;
    const float* src = W + (size_t)k0 * N + n0 + lane;
#pragma unroll 16
    for (int i = 0; i < 64; ++i) scr[i * 65 + lane] = __builtin_nontemporal_load(src + (size_t)i * N);
    asm volatile("s_waitcnt lgkmcnt(0)" ::: "memory");
    const int c = lane & 7;
#pragma unroll
    for (int j = 0; j < 8; ++j) { const int n = (lane >> 3) + 8 * j; const LAS float* s = scr + (8 * c) * 65 + n;
        u32x4 o; o.x = cvt_pk_bf16(s[0], s[65]); o.y = cvt_pk_bf16(s[2 * 65], s[3 * 65]); o.z = cvt_pk_bf16(s[4 * 65], s[5 * 65]); o.w = cvt_pk_bf16(s[6 * 65], s[7 * 65]);
        *(u32x4*)(WT + (size_t)(n0 + n) * K + k0 + 8 * c) = o; }
    asm volatile("s_waitcnt lgkmcnt(0)" ::: "memory");
}

__device__ __forceinline__ void prologue(const Params& p, LAS unsigned char* lds) {
    unsigned char* ws_ = opq(p.ws);
    const int tid = opaque_tid(), lane = tid & 63, wave = tid >> 6;
    LAS float* cs = (LAS float*)lds;
    LAS float* red = (LAS float*)(lds + 40960);
    for (int i = tid; i < 5 * DM; i += 512) { const float v = (i < 4 * DM) ? opq(p.c)[i] : opq(p.c_ctx)[i - 4 * DM]; cs[i] = v / (1.0f + expf(-v)); }
    __syncthreads();
    float* modv = (float*)(ws_ + WS_MODV);
    for (int item = blockIdx.x; item < 384; item += gridDim.x) {
        const int l = item / 96, cgp = item - l * 96;
        const float* W = opq(p.mod_w) + (size_t)l * DM * 6144 + cgp * 64 + lane;
        float a0 = 0.f, a1 = 0.f, a2 = 0.f, a3 = 0.f, a4 = 0.f;
        const int k0 = wave * 256;
#pragma unroll 8
        for (int k = k0; k < k0 + 256; ++k) { const float w = __builtin_nontemporal_load(W + (size_t)k * 6144); a0 += cs[k] * w; a1 += cs[DM + k] * w; a2 += cs[2 * DM + k] * w; a3 += cs[3 * DM + k] * w; a4 += cs[4 * DM + k] * w; }
        red[(wave * 5 + 0) * 64 + lane] = a0; red[(wave * 5 + 1) * 64 + lane] = a1; red[(wave * 5 + 2) * 64 + lane] = a2; red[(wave * 5 + 3) * 64 + lane] = a3; red[(wave * 5 + 4) * 64 + lane] = a4;
        __syncthreads();
        if (tid < 320) { const int r = tid >> 6; float s = 0.f;
#pragma unroll
            for (int w = 0; w < 8; ++w) s += red[(w * 5 + r) * 64 + lane];
            modv[(size_t)(l * 5 + r) * 6144 + cgp * 64 + lane] = s + opq(p.mod_b)[l * 6144 + cgp * 64 + lane]; }
        __syncthreads();
    }
    {
        const int gt = blockIdx.x * 512 + tid;
        if (gt < 4096) { const int pos = gt >> 6, f = gt & 63; const float freq = exp2f(-(float)f * (13.287712379549449f / 64.0f)); const float ang = (float)pos * freq;
            float sn, cn; sincosf(ang, &sn, &cn); ((f32x2*)(ws_ + WS_ROPE))[gt] = (f32x2){cn, sn}; }
    }
    __syncthreads();
    LAS float* scr = (LAS float*)(lds + wave * 16640);
    const int gw = blockIdx.x * 8 + wave, NGW = gridDim.x * 8;
    constexpr int I_RI = 32 * 192, I_NI = 32 * 256, I_O = 64 * 32;
    constexpr int NITEMS = 2 * I_RI + 2 * I_NI + 4 * I_O;
    for (int it = gw; it < NITEMS; it += NGW) {
        int r = it;
        if (r < I_RI) { transpose_item(opq(p.ret_w_in), DM, NP_RET, (bf16_t*)(ws_ + WS_WRI0), scr, r, lane); continue; } r -= I_RI;
        if (r < I_O) { transpose_item(opq(p.ret_w_out), EB, DM, (bf16_t*)(ws_ + WS_WRO0), scr, r, lane); continue; } r -= I_O;
        if (r < I_NI) { transpose_item(opq(p.na_w_in), DM, NP_NA, (bf16_t*)(ws_ + WS_WNI0), scr, r, lane); continue; } r -= I_NI;
        if (r < I_O) { transpose_item(opq(p.na_w_out), EB, DM, (bf16_t*)(ws_ + WS_WNO0), scr, r, lane); continue; } r -= I_O;
        if (r < I_RI) { transpose_item(opq(p.ret_w_in) + (size_t)DM * NP_RET, DM, NP_RET, (bf16_t*)(ws_ + WS_WRI1), scr, r, lane); continue; } r -= I_RI;
        if (r < I_O) { transpose_item(opq(p.ret_w_out) + (size_t)EB * DM, EB, DM, (bf16_t*)(ws_ + WS_WRO1), scr, r, lane); continue; } r -= I_O;
        if (r < I_NI) { transpose_item(opq(p.na_w_in) + (size_t)DM * NP_NA, DM, NP_NA, (bf16_t*)(ws_ + WS_WNI1), scr, r, lane); continue; } r -= I_NI;
        transpose_item(opq(p.na_w_out) + (size_t)EB * DM, EB, DM, (bf16_t*)(ws_ + WS_WNO1), scr, r, lane);
    }
    __syncthreads();
}

__device__ __forceinline__ void norm_emit(const f32x4 (&v)[8], const f32x4 (&gs)[8], const f32x4 (&sh)[8], bf16_t* hrow, int lane) {
    float ss = 0.f;
#pragma unroll
    for (int j = 0; j < 8; ++j) ss += (v[j][0] * v[j][0] + v[j][1] * v[j][1]) + (v[j][2] * v[j][2] + v[j][3] * v[j][3]);
    ss = wave_sum(ss);
    const float rstd = 1.0f / sqrtf(ss * (1.0f / DM) + EPS);
    u32x2* o = (u32x2*)hrow;
#pragma unroll
    for (int j = 0; j < 8; ++j) { const f32x4 hv = v[j] * rstd * gs[j] + sh[j];
        u32x2 w; w.x = cvt_pk_bf16(hv[0], hv[1]); w.y = cvt_pk_bf16(hv[2], hv[3]); o[lane + 64 * j] = w; }
}
__device__ __forceinline__ void norm_phase(const Params& p, int l) {
    unsigned char* ws_ = opq(p.ws);
    const int tid = opaque_tid(), lane = tid & 63, wave = tid >> 6;
    const int gw = blockIdx.x * 8 + wave, NGW = gridDim.x * 8;
    float* XS = (float*)(ws_ + WS_XS);
    const float* modv = (const float*)(ws_ + WS_MODV);
    const float* PART = (const float*)(ws_ + WS_PART);
    bf16_t* H = (bf16_t*)(ws_ + WS_H);
    const f32x4* g4 = (const f32x4*)(opq(p.norm_g) + l * DM);
    f32x4 gg[8];
#pragma unroll
    for (int j = 0; j < 8; ++j) gg[j] = g4[lane + 64 * j];
    for (int m = ML + gw; m < MT; m += NGW) {
        const float* src = (l <= 1) ? opq(p.ctx) + (size_t)(m - ML) * DM : XS + (size_t)m * DM;
        const f32x4* sh4 = (const f32x4*)(modv + (size_t)(l * 5 + 4) * 6144);
        f32x4 v[8], gs[8], sh[8];
#pragma unroll
        for (int j = 0; j < 8; ++j) { v[j] = ((const f32x4*)src)[lane + 64 * j]; gs[j] = gg[j] * (sh4[DM / 4 + lane + 64 * j] + 1.0f); sh[j] = sh4[lane + 64 * j]; }
        if (l != 0) {
            const f32x4* gt4 = (const f32x4*)(modv + (size_t)((l - 1) * 5 + 4) * 6144 + 4096);
            const f32x4* pp = (const f32x4*)(PART + (size_t)(m - ML) * DM);
#pragma unroll
            for (int j = 0; j < 8; ++j) { f32x4 a = (f32x4){0.f, 0.f, 0.f, 0.f};
#pragma unroll
                for (int sp = 0; sp < 8; ++sp) a += pp[(size_t)sp * (MC * DM / 4) + lane + 64 * j];
                v[j] += gt4[lane + 64 * j] * a; }
#pragma unroll
            for (int j = 0; j < 8; ++j) ((f32x4*)(XS + (size_t)m * DM))[lane + 64 * j] = v[j];
        }
        norm_emit(v, gs, sh, H + (size_t)m * DM, lane);
    }
    const float* lsrc = (l == 0) ? opq(p.x) : (const float*)XS;
    int pstart = gw, pend = ML / 2, pstep = NGW;
    if (l > 0 && NGW == 2048) { if (gw < 1024) { pstart = gw; pend = gw + 1; } else { pstart = 1024 + (gw - 1024) * 3; pend = pstart + 3; } pstep = 1; }
    for (int pi = pstart; pi < pend; pi += pstep) {
        const int m0 = pi * 2;
        const f32x4* sh4 = (const f32x4*)(modv + (size_t)(l * 5 + (m0 >> 11)) * 6144);
        f32x4 va[8], vb[8], gs[8], sh[8];
#pragma unroll
        for (int j = 0; j < 8; ++j) { va[j] = ((const f32x4*)(lsrc + (size_t)m0 * DM))[lane + 64 * j]; vb[j] = ((const f32x4*)(lsrc + (size_t)(m0 + 1) * DM))[lane + 64 * j];
            gs[j] = gg[j] * (sh4[DM / 4 + lane + 64 * j] + 1.0f); sh[j] = sh4[lane + 64 * j]; }
        norm_emit(va, gs, sh, H + (size_t)m0 * DM, lane);
        norm_emit(vb, gs, sh, H + (size_t)(m0 + 1) * DM, lane);
    }
}
__device__ __forceinline__ void final_norm(const Params& p) {
    unsigned char* ws_ = opq(p.ws);
    const int tid = opaque_tid(), lane = tid & 63, wave = tid >> 6;
    const int gw = blockIdx.x * 8 + wave, NGW = gridDim.x * 8;
    const float* XS = (const float*)(ws_ + WS_XS);
    const f32x4* g4 = (const f32x4*)opq(p.final_g);
    float* outp = opq(p.out);
    f32x4 gg[8];
#pragma unroll
    for (int j = 0; j < 8; ++j) gg[j] = g4[lane + 64 * j];
    for (int m0 = gw * 2; m0 < ML; m0 += NGW * 2) {
        f32x4 v[2][8];
#pragma unroll
        for (int q = 0; q < 2; ++q)
#pragma unroll
            for (int j = 0; j < 8; ++j) v[q][j] = ((const f32x4*)(XS + (size_t)(m0 + q) * DM))[lane + 64 * j];
#pragma unroll
        for (int q = 0; q < 2; ++q) { float ss = 0.f;
#pragma unroll
            for (int j = 0; j < 8; ++j) ss += (v[q][j][0] * v[q][j][0] + v[q][j][1] * v[q][j][1]) + (v[q][j][2] * v[q][j][2] + v[q][j][3] * v[q][j][3]);
            ss = wave_sum(ss);
            const float rstd = 1.0f / sqrtf(ss * (1.0f / DM) + EPS);
            f32x4* o = (f32x4*)(outp + (size_t)(m0 + q) * DM);
#pragma unroll
            for (int j = 0; j < 8; ++j) o[lane + 64 * j] = v[q][j] * rstd * gg[j];
        }
    }
}

constexpr int RQ_STRIDE = 528, RK_STRIDE = 544, RV_STRIDE = 288, RP_STRIDE = 144;
constexpr int R_QS = 0, R_KS = 33792, R_VS = 68608, R_PS = 87040;
__device__ __forceinline__ void ret_phaseA(const Params& p, int j, LAS unsigned char* lds) {
    unsigned char* ws_ = opq(p.ws);
    const int tid = opaque_tid(), lane = tid & 63, w = __builtin_amdgcn_readfirstlane(tid >> 6), g = lane >> 4, li = lane & 15;
    const int tq = li >> 2, tp = li & 3;
    const bf16_t* PROJ = (const bf16_t*)(ws_ + WS_PROJ);
    bf16_t* OFB = (bf16_t*)(ws_ + WS_OFB);
    const f32x2* rope = (const f32x2*)(ws_ + WS_ROPE);
    LAS unsigned char* Qs = lds + R_QS; LAS unsigned char* Ks = lds + R_KS; LAS unsigned char* Vs = lds + R_VS; LAS unsigned char* Ps = lds + R_PS;
    for (int u = blockIdx.x; u < 256; u += gridDim.x) {
        const int slice = (u >> 3) & 3, grp = (u & 7) | ((u >> 5) << 3), dir = grp & 1, h = (grp >> 1) & 7, b = grp >> 4;
        const float raw = (dir ? opq(p.ret_db) : opq(p.ret_df))[j * 8 + h];
        const float lg = -log1pf(expf(raw));
        const float cdec = expf(lg * 64.0f);
        f32x4 S[16];
#pragma unroll
        for (int i = 0; i < 16; ++i) S[i] = (f32x4){0.f, 0.f, 0.f, 0.f};
        u32x4 pq[2][2], pk[2][2], pv[2];
#define RET_ROWBASE(s, rb, cc, isctx) do { isctx = (s) < 4; const int ci_ = isctx ? (s) : (s) - 4; const int nch_ = isctx ? 4 : 32; cc = dir ? nch_ - 1 - ci_ : ci_; \
        rb = isctx ? ML + b * CTXL + cc * 64 : b * SEQ + cc * 64; } while (0)
#define RET_LOAD(s) do { int rb_, cc_; bool ic_; RET_ROWBASE(s, rb_, cc_, ic_); _Pragma("unroll") for (int t = 0; t < 2; ++t) { const int tk = tid + 512 * t; const int row = tk >> 4, sub = tk & 15; \
        const int d0 = (sub >> 3) * 128 + (sub & 7) * 8; const bf16_t* sp = PROJ + (size_t)(rb_ + row) * NP_RET + h * 256 + d0; \
        pq[t][0] = *(const u32x4*)sp; pq[t][1] = *(const u32x4*)(sp + 64); pk[t][0] = *(const u32x4*)(sp + 2048); pk[t][1] = *(const u32x4*)(sp + 2048 + 64); \
        pv[t] = *(const u32x4*)(PROJ + (size_t)(rb_ + row) * NP_RET + 4096 + h * 512 + slice * 128 + sub * 8); } } while (0)
        RET_LOAD(0);
        for (int s = 0; s < 36; ++s) {
            int rowbase, cc; bool isctx; RET_ROWBASE(s, rowbase, cc, isctx);
#pragma unroll
            for (int t = 0; t < 2; ++t) {
                const int tk = tid + 512 * t; const int row = tk >> 4, sub = tk & 15; const int half = sub >> 3, gq = sub & 7; const int d0 = half * 128 + gq * 8;
                const float e_i = dir ? (float)(64 - row) : (float)(row + 1);
                const float fqs = expf(lg * e_i), fks = expf(-lg * e_i) * 0.0625f;
                float q1[8], q2[8], k1[8], k2[8];
#pragma unroll
                for (int e = 0; e < 4; ++e) { q1[2 * e] = bf_lo(pq[t][0][e]); q1[2 * e + 1] = bf_hi(pq[t][0][e]); q2[2 * e] = bf_lo(pq[t][1][e]); q2[2 * e + 1] = bf_hi(pq[t][1][e]);
                    k1[2 * e] = bf_lo(pk[t][0][e]); k1[2 * e + 1] = bf_hi(pk[t][0][e]); k2[2 * e] = bf_lo(pk[t][1][e]); k2[2 * e + 1] = bf_hi(pk[t][1][e]); }
                if (!isctx) {
                    const int pos = half ? row : cc;
                    const f32x4* rp = (const f32x4*)(rope + pos * 64 + gq * 8);
#pragma unroll
                    for (int e = 0; e < 4; ++e) { const f32x4 cs2 = rp[e];
                        { const float c0 = cs2[0], s0 = cs2[1]; const float a = q1[2 * e], bb = q2[2 * e]; q1[2 * e] = a * c0 - bb * s0; q2[2 * e] = a * s0 + bb * c0;
                          const float ka = k1[2 * e], kb = k2[2 * e]; k1[2 * e] = ka * c0 - kb * s0; k2[2 * e] = ka * s0 + kb * c0; }
                        { const float c0 = cs2[2], s0 = cs2[3]; const float a = q1[2 * e + 1], bb = q2[2 * e + 1]; q1[2 * e + 1] = a * c0 - bb * s0; q2[2 * e + 1] = a * s0 + bb * c0;
                          const float ka = k1[2 * e + 1], kb = k2[2 * e + 1]; k1[2 * e + 1] = ka * c0 - kb * s0; k2[2 * e + 1] = ka * s0 + kb * c0; } }
                }
                u32x4 o;
                o.x = cvt_pk_bf16(q1[0] * fqs, q1[1] * fqs); o.y = cvt_pk_bf16(q1[2] * fqs, q1[3] * fqs); o.z = cvt_pk_bf16(q1[4] * fqs, q1[5] * fqs); o.w = cvt_pk_bf16(q1[6] * fqs, q1[7] * fqs);
                *(LAS u32x4*)(Qs + row * RQ_STRIDE + d0 * 2) = o;
                o.x = cvt_pk_bf16(q2[0] * fqs, q2[1] * fqs); o.y = cvt_pk_bf16(q2[2] * fqs, q2[3] * fqs); o.z = cvt_pk_bf16(q2[4] * fqs, q2[5] * fqs); o.w = cvt_pk_bf16(q2[6] * fqs, q2[7] * fqs);
                *(LAS u32x4*)(Qs + row * RQ_STRIDE + (d0 + 64) * 2) = o;
                o.x = cvt_pk_bf16(k1[0] * fks, k1[1] * fks); o.y = cvt_pk_bf16(k1[2] * fks, k1[3] * fks); o.z = cvt_pk_bf16(k1[4] * fks, k1[5] * fks); o.w = cvt_pk_bf16(k1[6] * fks, k1[7] * fks);
                *(LAS u32x4*)(Ks + row * RK_STRIDE + d0 * 2) = o;
                o.x = cvt_pk_bf16(k2[0] * fks, k2[1] * fks); o.y = cvt_pk_bf16(k2[2] * fks, k2[3] * fks); o.z = cvt_pk_bf16(k2[4] * fks, k2[5] * fks); o.w = cvt_pk_bf16(k2[6] * fks, k2[7] * fks);
                *(LAS u32x4*)(Ks + row * RK_STRIDE + (d0 + 64) * 2) = o;
                *(LAS u32x4*)(Vs + row * RV_STRIDE + sub * 16) = pv[t];
            }
            __syncthreads();
            if (s + 1 < 36) RET_LOAD(s + 1);
            {
                const int ib = w >> 1;
#pragma unroll
                for (int t = 0; t < 2; ++t) {
                    const int jb = 2 * (w & 1) + t;
                    f32x4 acc = (f32x4){0.f, 0.f, 0.f, 0.f};
                    const bool nz = dir ? (jb >= ib) : (jb <= ib);
                    if (nz) {
                        const LAS unsigned char* kp_ = Ks + (jb * 16 + li) * RK_STRIDE + (8 * g) * 2; const LAS unsigned char* qp_ = Qs + (ib * 16 + li) * RQ_STRIDE + (8 * g) * 2;
                        bf16x8 na_ = *(const LAS bf16x8*)kp_, nb_ = *(const LAS bf16x8*)qp_, na2_ = *(const LAS bf16x8*)(kp_ + 64), nb2_ = *(const LAS bf16x8*)(qp_ + 64);
#pragma unroll
                        for (int kk = 0; kk < 8; ++kk) {
                            const bf16x8 a = na_, bq = nb_; na_ = na2_; nb_ = nb2_;
                            if (kk + 2 < 8) { na2_ = *(const LAS bf16x8*)(kp_ + (kk + 2) * 64); nb2_ = *(const LAS bf16x8*)(qp_ + (kk + 2) * 64); }
                            acc = __builtin_amdgcn_mfma_f32_16x16x32_bf16(a, bq, acc, 0, 0, 0);
                            __builtin_amdgcn_sched_barrier(0);
                        }
                        const int i = ib * 16 + li;
#pragma unroll
                        for (int r = 0; r < 4; ++r) { const int jj = jb * 16 + 4 * g + r; const bool keep = dir ? (jj >= i) : (jj <= i); acc[r] = keep ? acc[r] : 0.f; }
                    }
                    u32x2 wv; wv.x = cvt_pk_bf16(acc[0], acc[1]); wv.y = cvt_pk_bf16(acc[2], acc[3]);
                    *(LAS u32x2*)(Ps + (ib * 16 + li) * RP_STRIDE + (jb * 16 + 4 * g) * 2) = wv;
                }
            }
            f32x4 oacc[4];
#pragma unroll
            for (int ib = 0; ib < 4; ++ib) oacc[ib] = (f32x4){0.f, 0.f, 0.f, 0.f};
            {
                const LAS unsigned char* qa0 = Qs + li * RQ_STRIDE + (4 * g) * 2;
#define RET_QF(idx) cat8(*(const LAS s16x4*)(qa0 + ((idx) & 3) * 16 * RQ_STRIDE + ((idx) >> 2) * 64), *(const LAS s16x4*)(qa0 + ((idx) & 3) * 16 * RQ_STRIDE + ((idx) >> 2) * 64 + 32))
                bf16x8 qn0 = RET_QF(0), qn1 = RET_QF(1), qn2 = RET_QF(2);
#pragma unroll
                for (int T = 0; T < 8; ++T) {
                    const bf16x8 bfrag = pack8(S[2 * T], S[2 * T + 1]);
#pragma unroll
                    for (int ib = 0; ib < 4; ++ib) {
                        const int idx = T * 4 + ib; const bf16x8 a = qn0; qn0 = qn1; qn1 = qn2;
                        if (idx + 3 < 32) qn2 = RET_QF(idx + 3);
                        oacc[ib] = __builtin_amdgcn_mfma_f32_16x16x32_bf16(a, bfrag, oacc[ib], 0, 0, 0);
                        __builtin_amdgcn_sched_barrier(0);
                    }
                }
#undef RET_QF
            }
            bf16x8 vfrag[2];
#pragma unroll
            for (int ks = 0; ks < 2; ++ks) {
                LAS unsigned char* va = Vs + (32 * ks + 4 * g + tq) * RV_STRIDE + (w * 16 + 4 * tp) * 2;
                vfrag[ks] = cat8(tr_read(va), tr_read(va + 16 * RV_STRIDE));
            }
            {
                LAS unsigned char* ka0 = Ks + (4 * g + tq) * RK_STRIDE + (4 * tp) * 2;
#define RET_KF(idx) cat8(tr_read(ka0 + ((idx) & 1) * 32 * RK_STRIDE + ((idx) >> 1) * 32), tr_read(ka0 + ((idx) & 1) * 32 * RK_STRIDE + ((idx) >> 1) * 32 + 16 * RK_STRIDE))
                bf16x8 kn0 = RET_KF(0), kn1 = RET_KF(1), kn2 = RET_KF(2);
#pragma unroll
                for (int dkb = 0; dkb < 16; ++dkb) {
#pragma unroll
                    for (int ks = 0; ks < 2; ++ks) {
                        const int idx = dkb * 2 + ks; const bf16x8 a = kn0; kn0 = kn1; kn1 = kn2;
                        if (idx + 3 < 32) kn2 = RET_KF(idx + 3);
                        S[dkb] = __builtin_amdgcn_mfma_f32_16x16x32_bf16(a, vfrag[ks], S[dkb], 0, 0, 0);
                        __builtin_amdgcn_sched_barrier(0);
                    }
                    S[dkb] = S[dkb] * cdec;
                }
#undef RET_KF
            }
            __syncthreads();
#pragma unroll
            for (int ib = 0; ib < 4; ++ib)
#pragma unroll
                for (int ks = 0; ks < 2; ++ks) {
                    const LAS unsigned char* pa = Ps + (ib * 16 + li) * RP_STRIDE + (32 * ks + 4 * g) * 2;
                    const bf16x8 a = cat8(*(const LAS s16x4*)pa, *(const LAS s16x4*)(pa + 32));
                    oacc[ib] = __builtin_amdgcn_mfma_f32_16x16x32_bf16(a, vfrag[ks], oacc[ib], 0, 0, 0);
                }
            {
                bf16_t* ob = OFB + ((size_t)dir * MT + rowbase) * EB + h * 512 + slice * 128 + w * 16 + li;
#pragma unroll
                for (int ib = 0; ib < 4; ++ib)
#pragma unroll
                    for (int r = 0; r < 4; ++r) { const unsigned pk2 = cvt_pk_bf16(oacc[ib][r], 0.f); ob[(size_t)(ib * 16 + 4 * g + r) * EB] = (bf16_t)(pk2 & 0xffffu); }
            }
        }
#undef RET_LOAD
#undef RET_ROWBASE
    }
}
__device__ __forceinline__ void ret_phaseB(const Params& p) {
    unsigned char* ws_ = opq(p.ws);
    const int tid = opaque_tid(), lane = tid & 63, wave = tid >> 6;
    const int gw = blockIdx.x * 8 + wave, NGW = gridDim.x * 8;
    const bf16_t* PROJ = (const bf16_t*)(ws_ + WS_PROJ);
    const bf16_t* OFB = (const bf16_t*)(ws_ + WS_OFB);
    bf16_t* GATED = (bf16_t*)(ws_ + WS_GATED);
    for (int it0 = gw * 6; it0 < MT * 8; it0 += NGW * 6) {
        u32x4 of[6], ob[6], gg[6];
#pragma unroll
        for (int q = 0; q < 6; ++q) { const int item = it0 + q; const int m = item >> 3, h = item & 7; const size_t off = (size_t)m * EB + h * 512 + lane * 8;
            of[q] = *(const u32x4*)(OFB + off); ob[q] = *(const u32x4*)(OFB + (size_t)MT * EB + off); gg[q] = *(const u32x4*)(PROJ + (size_t)m * NP_RET + 8192 + h * 512 + lane * 8); }
#pragma unroll
        for (int q = 0; q < 6; ++q) { const int item = it0 + q; const int m = item >> 3, h = item & 7; const size_t off = (size_t)m * EB + h * 512 + lane * 8;
            float o[8]; float ss = 0.f;
#pragma unroll
            for (int e = 0; e < 4; ++e) { o[2 * e] = bf_lo(of[q][e]) + bf_lo(ob[q][e]); o[2 * e + 1] = bf_hi(of[q][e]) + bf_hi(ob[q][e]); ss += o[2 * e] * o[2 * e] + o[2 * e + 1] * o[2 * e + 1]; }
            ss = wave_sum(ss);
            const float rn = 1.0f / sqrtf(ss * (1.0f / 512.0f) + EPS);
            u32x4 r;
#pragma unroll
            for (int e = 0; e < 4; ++e) { const float g0 = bf_lo(gg[q][e]), g1 = bf_hi(gg[q][e]); r[e] = cvt_pk_bf16(silu_f(g0) * o[2 * e] * rn, silu_f(g1) * o[2 * e + 1] * rn); }
            *(u32x4*)(GATED + off) = r; }
    }
}

constexpr int NA_KSTR = 272, NA_VSTR = 288, NA_VOFF = 17408, NA_BUF = 35840, NA_RPB = 71680, NA_QOFF = 73728, NA_QW = 8704;
constexpr float LOG2E = 1.4426950408889634f;
struct NaQ { f32x4 o[8]; float m, l, pend; };
__device__ __forceinline__ bf16x8 na_softmax(const f32x4 s0, const f32x4 s1, NaQ& q, const bool first) {
    const float x = fmaxf(fmaxf(fmaxf(s0[0], s0[1]), fmaxf(s0[2], s0[3])), fmaxf(fmaxf(s1[0], s1[1]), fmaxf(s1[2], s1[3])));
    const float xa = __shfl_xor(x, 16), xb = __shfl_xor(x, 32), xc = __shfl_xor(x, 48);
    if (first) { const float tmax = fmaxf(fmaxf(x, xa), fmaxf(xb, xc)); q.m = tmax; q.pend = tmax; }
    else {
        const bool need = q.pend > q.m + 8.0f;
        if (__builtin_amdgcn_ballot_w64(need) != 0ull) {
            const float mnew = need ? q.pend : q.m; const float alpha = __builtin_amdgcn_exp2f(q.m - mnew);
#pragma unroll
            for (int db = 0; db < 8; ++db) q.o[db] = q.o[db] * alpha;
            q.l *= alpha; q.m = mnew;
        }
    }
    f32x4 p0, p1;
#pragma unroll
    for (int rr = 0; rr < 4; ++rr) { p0[rr] = __builtin_amdgcn_exp2f(s0[rr] - q.m); p1[rr] = __builtin_amdgcn_exp2f(s1[rr] - q.m); }
    q.l += ((p0[0] + p0[1]) + (p0[2] + p0[3])) + ((p1[0] + p1[1]) + (p1[2] + p1[3]));
    const bf16x8 pf = pack8(p0, p1);
    if (!first) q.pend = fmaxf(q.pend, fmaxf(fmaxf(x, xa), fmaxf(xb, xc)));
    return pf;
}
__device__ __forceinline__ void na_group2(const bool f0, const bool f1, const LAS unsigned char* Qw, LAS unsigned char* Kb, LAS unsigned char* Vb, int cb, bool local, int rb0, const LAS float* rpbs, float sc2,
                                          unsigned vmask, int cbase, NaQ& q0, NaQ& q1, int li, int g, int tq, int tp) {
    f32x4 s00 = (f32x4){0.f, 0.f, 0.f, 0.f}, s01 = s00, s10 = s00, s11 = s00;
#pragma unroll
    for (int kk = 0; kk < 4; ++kk) {
        const bf16x8 ka = *(const LAS bf16x8*)(Kb + (cb + li) * NA_KSTR + (kk * 32 + 8 * g) * 2);
        const bf16x8 kb = *(const LAS bf16x8*)(Kb + (cb + 16 + li) * NA_KSTR + (kk * 32 + 8 * g) * 2);
        const bf16x8 qa = *(const LAS bf16x8*)(Qw + li * NA_KSTR + (kk * 32 + 8 * g) * 2);
        const bf16x8 qb2 = *(const LAS bf16x8*)(Qw + (16 + li) * NA_KSTR + (kk * 32 + 8 * g) * 2);
        s00 = __builtin_amdgcn_mfma_f32_16x16x32_bf16(ka, qa, s00, 0, 0, 0); s01 = __builtin_amdgcn_mfma_f32_16x16x32_bf16(kb, qa, s01, 0, 0, 0);
        s10 = __builtin_amdgcn_mfma_f32_16x16x32_bf16(ka, qb2, s10, 0, 0, 0); s11 = __builtin_amdgcn_mfma_f32_16x16x32_bf16(kb, qb2, s11, 0, 0, 0);
    }
    s00 = s00 * sc2; s01 = s01 * sc2; s10 = s10 * sc2; s11 = s11 * sc2;
    if (local) { const int rb1 = rb0 - 31;
#pragma unroll
        for (int k = 0; k < 4; ++k) { const bool v0 = (vmask >> k) & 1u, v1 = (vmask >> (k + 4)) & 1u;
            const int c0 = min(max(cbase + k, 0), 30), c1 = min(max(cbase + 16 + k, 0), 30);
            float b00 = rpbs[rb0 + c0], b01 = rpbs[rb0 + c1], b10 = rpbs[rb1 + c0], b11 = rpbs[rb1 + c1];
            asm volatile("" : "+v"(b00), "+v"(b01), "+v"(b10), "+v"(b11));
            s00[k] = v0 ? s00[k] + b00 : -INFINITY; s01[k] = v1 ? s01[k] + b01 : -INFINITY;
            s10[k] = v0 ? s10[k] + b10 : -INFINITY; s11[k] = v1 ? s11[k] + b11 : -INFINITY; } }
    const bf16x8 pf0 = na_softmax(s00, s01, q0, f0);
    const bf16x8 pf1 = na_softmax(s10, s11, q1, f1);
    LAS unsigned char* va0 = Vb + (cb + 4 * g + tq) * NA_VSTR + (4 * tp) * 2;
    bf16x8 an0 = cat8(tr_read(va0), tr_read(va0 + 16 * NA_VSTR));
    bf16x8 an1 = cat8(tr_read(va0 + 32), tr_read(va0 + 32 + 16 * NA_VSTR));
    bf16x8 an2 = cat8(tr_read(va0 + 64), tr_read(va0 + 64 + 16 * NA_VSTR));
#pragma unroll
    for (int db = 0; db < 8; ++db) {
        const bf16x8 a = an0; an0 = an1; an1 = an2;
        if (db + 3 < 8) { LAS unsigned char* va = va0 + (db + 3) * 32; an2 = cat8(tr_read(va), tr_read(va + 16 * NA_VSTR)); }
        q0.o[db] = __builtin_amdgcn_mfma_f32_16x16x32_bf16(a, pf0, q0.o[db], 0, 0, 0);
        q1.o[db] = __builtin_amdgcn_mfma_f32_16x16x32_bf16(a, pf1, q1.o[db], 0, 0, 0);
        __builtin_amdgcn_sched_barrier(0);
    }
}
__device__ __forceinline__ void na_group1(const bool f, const LAS unsigned char* Qw, LAS unsigned char* Kb, LAS unsigned char* Vb, int cb, int rb, const LAS float* rpbs, float sc2,
                                          unsigned vmask, int cbase, NaQ& q, int li, int g, int tq, int tp) {
    f32x4 s0 = (f32x4){0.f, 0.f, 0.f, 0.f}, s1 = s0;
#pragma unroll
    for (int kk = 0; kk < 4; ++kk) {
        const bf16x8 ka = *(const LAS bf16x8*)(Kb + (cb + li) * NA_KSTR + (kk * 32 + 8 * g) * 2);
        const bf16x8 kb = *(const LAS bf16x8*)(Kb + (cb + 16 + li) * NA_KSTR + (kk * 32 + 8 * g) * 2);
        const bf16x8 qa = *(const LAS bf16x8*)(Qw + li * NA_KSTR + (kk * 32 + 8 * g) * 2);
        s0 = __builtin_amdgcn_mfma_f32_16x16x32_bf16(ka, qa, s0, 0, 0, 0); s1 = __builtin_amdgcn_mfma_f32_16x16x32_bf16(kb, qa, s1, 0, 0, 0);
    }
    s0 = s0 * sc2; s1 = s1 * sc2;
#pragma unroll
    for (int k = 0; k < 4; ++k) { const bool v0 = (vmask >> k) & 1u, v1 = (vmask >> (k + 4)) & 1u;
        const int c0 = min(max(cbase + k, 0), 30), c1 = min(max(cbase + 16 + k, 0), 30);
        float b0 = rpbs[rb + c0], b1 = rpbs[rb + c1]; asm volatile("" : "+v"(b0), "+v"(b1));
        s0[k] = v0 ? s0[k] + b0 : -INFINITY; s1[k] = v1 ? s1[k] + b1 : -INFINITY; }
    const bf16x8 pf = na_softmax(s0, s1, q, f);
    LAS unsigned char* va0 = Vb + (cb + 4 * g + tq) * NA_VSTR + (4 * tp) * 2;
    bf16x8 an0 = cat8(tr_read(va0), tr_read(va0 + 16 * NA_VSTR));
    bf16x8 an1 = cat8(tr_read(va0 + 32), tr_read(va0 + 32 + 16 * NA_VSTR));
#pragma unroll
    for (int db = 0; db < 8; ++db) {
        const bf16x8 a = an0; an0 = an1;
        if (db + 2 < 8) { LAS unsigned char* va = va0 + (db + 2) * 32; an1 = cat8(tr_read(va), tr_read(va + 16 * NA_VSTR)); }
        q.o[db] = __builtin_amdgcn_mfma_f32_16x16x32_bf16(a, pf, q.o[db], 0, 0, 0);
        __builtin_amdgcn_sched_barrier(0);
    }
}
__device__ __forceinline__ void na_phase(const Params& p, int j, bool with_ctx, LAS unsigned char* lds) {
    unsigned char* ws_ = opq(p.ws);
    const int tid = opaque_tid(), lane = tid & 63, w = __builtin_amdgcn_readfirstlane(tid >> 6), g = lane >> 4, li = lane & 15;
    const int tq = li >> 2, tp = li & 3;
    const bf16_t* PROJ = (const bf16_t*)(ws_ + WS_PROJ);
    bf16_t* GATED = (bf16_t*)(ws_ + WS_GATED);
    LAS float* rpbs = (LAS float*)(lds + NA_RPB);
    const float sc2 = 0.08838834764831845f * LOG2E;
    const int NU = 1024 + (with_ctx ? 128 : 0);
    for (int u = blockIdx.x; u < NU; u += gridDim.x) {
        const bool isctx = u >= 1024;
        int b, head, qb = 0, r0 = 0, rs0 = 0, nloc = 0, qrow0, qrow1, rsw0 = 0, rsw1 = 0;
        if (!isctx) {
            const int rnd = u / (int)gridDim.x, bx = u - rnd * (int)gridDim.x; const int grp = (gridDim.x == 256) ? rnd * 32 + (bx & 7) * 4 + (bx >> 6) : (u >> 3);
            const int rq = (gridDim.x == 256) ? ((bx >> 3) & 7) : (u & 7); b = grp >> 5; head = grp & 31; qb = w & 3; r0 = 4 * rq + 2 * (w >> 2);
            qrow0 = b * SEQ + r0 * 64 + qb * 16; qrow1 = qrow0 + 64; rsw0 = min(max(r0 - 4, 0), 24); rsw1 = min(max(r0 - 3, 0), 24);
            rs0 = min(max(4 * rq - 4, 0), 24); nloc = min(max(4 * rq - 1, 0), 24) + 8 - rs0; }
        else { const int v = u - 1024; b = v >> 5; head = v & 31; qrow0 = ML + b * CTXL + w * 16; qrow1 = qrow0 + 128; }
        const int nit = nloc + 4;
        const int cb_loc = (qb == 0) ? 0 : (qb == 1) ? 8 : (qb == 2) ? 24 : 32;
        if (tid < 465) rpbs[tid] = opq(p.na_rpb)[(size_t)(j * 32 + head) * 465 + tid] * LOG2E;
        unsigned vmask = 0; const int cbase = cb_loc + 4 * g - (qb * 16 + li) + 15;
        { const int qc = qb * 16 + li; const int wsx = min(max(qc - 8, 0), 48);
#pragma unroll
          for (int k = 0; k < 8; ++k) { const int kc = cb_loc + (k >> 2) * 16 + 4 * g + (k & 3); vmask |= ((kc >= wsx) && (kc < wsx + 16)) ? (1u << k) : 0u; } }
        NaQ q0, q1;
        LAS unsigned char* Qw = lds + NA_QOFF + w * NA_QW;
#pragma unroll
        for (int db = 0; db < 8; ++db) { q0.o[db] = (f32x4){0.f, 0.f, 0.f, 0.f}; q1.o[db] = (f32x4){0.f, 0.f, 0.f, 0.f}; }
        q0.m = 0.f; q1.m = 0.f; q0.l = 0.f; q1.l = 0.f; q0.pend = 0.f; q1.pend = 0.f;
        u32x4 pA[2][2];
#define NA_LOAD(it, R) do { const int trow_ = ((it) < nloc) ? b * SEQ + (rs0 + (it)) * 64 : ML + b * CTXL + ((it) - nloc) * 64; _Pragma("unroll") for (int t = 0; t < 2; ++t) { const int idx = tid + 512 * t; \
        const bf16_t* sp = PROJ + (size_t)(trow_ + (idx >> 4)) * NP_NA + 4096 + head * 128 + (idx & 15) * 8; R[t][0] = *(const u32x4*)sp; R[t][1] = *(const u32x4*)(sp + 4096); } } while (0)
#define NA_STORE(buf, R) do { _Pragma("unroll") for (int t = 0; t < 2; ++t) { const int idx = tid + 512 * t; LAS unsigned char* dp = lds + (buf) * NA_BUF; \
        *(LAS u32x4*)(dp + (idx >> 4) * NA_KSTR + (idx & 15) * 16) = R[t][0]; *(LAS u32x4*)(dp + NA_VOFF + (idx >> 4) * NA_VSTR + (idx & 15) * 16) = R[t][1]; } } while (0)
        {
            u32x4 qv[8];
#pragma unroll
            for (int i = 0; i < 8; ++i) { const int c = lane + 64 * i, row = c >> 4, ch = c & 15;
                qv[i] = *(const u32x4*)(PROJ + (size_t)((row < 16 ? qrow0 : qrow1) + (row & 15)) * NP_NA + head * 128 + ch * 8); }
            NA_LOAD(0, pA);
#pragma unroll
            for (int i = 0; i < 8; ++i) { const int c = lane + 64 * i, row = c >> 4, ch = c & 15; *(LAS u32x4*)(Qw + row * NA_KSTR + ch * 16) = qv[i]; }
            NA_STORE(0, pA);
        }
        __syncthreads();
        for (int it = 0; it < nit; ++it) {
            const int cur = it & 1;
            if (it + 1 < nit) NA_LOAD(it + 1, pA);
            const bool local = it < nloc; const int kr = rs0 + it;
            LAS unsigned char* Kb = lds + cur * NA_BUF; LAS unsigned char* Vb = Kb + NA_VOFF;
            if (local) {
                const bool act0 = (kr >= rsw0 && kr < rsw0 + 8), act1 = (kr >= rsw1 && kr < rsw1 + 8); const int rb0 = (kr - r0 + 7) * 31;
                if (act0 && act1) na_group2(kr == rsw0, kr == rsw1, Qw, Kb, Vb, cb_loc, true, rb0, rpbs, sc2, vmask, cbase, q0, q1, li, g, tq, tp);
                else if (act0) na_group1(kr == rsw0, Qw, Kb, Vb, cb_loc, rb0, rpbs, sc2, vmask, cbase, q0, li, g, tq, tp);
                else if (act1) na_group1(kr == rsw1, Qw + 16 * NA_KSTR, Kb, Vb, cb_loc, rb0 - 31, rpbs, sc2, vmask, cbase, q1, li, g, tq, tp);
            } else {
                const bool f_ = isctx && it == 0;
                for (int gi = 0; gi < 2; ++gi) na_group2(f_ && gi == 0, f_ && gi == 0, Qw, Kb, Vb, gi * 32, false, 0, rpbs, sc2, vmask, cbase, q0, q1, li, g, tq, tp);
            }
            if (it + 1 < nit) NA_STORE(cur ^ 1, pA);
            __syncthreads();
        }
#undef NA_LOAD
#undef NA_STORE
#pragma unroll
        for (int t = 0; t < 2; ++t) {
            float lt = t ? q1.l : q0.l; lt += __shfl_xor(lt, 16); lt += __shfl_xor(lt, 32);
            const float inv = 1.0f / lt; const size_t row = (size_t)((t ? qrow1 : qrow0) + li);
#pragma unroll
            for (int db = 0; db < 8; ++db) { const int d = db * 16 + 4 * g; const f32x4 ov = t ? q1.o[db] : q0.o[db];
                const u32x2 gg = *(const u32x2*)(PROJ + row * NP_NA + 12288 + head * 128 + d);
                u32x2 wv; wv.x = cvt_pk_bf16(ov[0] * inv * silu_f(bf_lo(gg.x)), ov[1] * inv * silu_f(bf_hi(gg.x)));
                wv.y = cvt_pk_bf16(ov[2] * inv * silu_f(bf_lo(gg.y)), ov[3] * inv * silu_f(bf_hi(gg.y)));
                *(u32x2*)(GATED + row * EB + head * 128 + d) = wv; }
        }
    }
}

#define XB_TMO      128
#define XB_XCNT(j)  (256  + 64 * (j))
#define XB_XSUB(j)  (1280 + 64 * (j))
#define XB_XGEN(j)  (2304 + 64 * (j))
#define XB_TOP      3328
#define XB_TOPGEN   3392
#define XCD_BAR_WORDS 3456
#define XB_SPIN_CAP (1u << 20)
__device__ __forceinline__ unsigned xb_ld(unsigned* p)              { return __hip_atomic_load(p, __ATOMIC_RELAXED, __HIP_MEMORY_SCOPE_AGENT); }
__device__ __forceinline__ unsigned xb_add(unsigned* p, unsigned v) { return __hip_atomic_fetch_add(p, v, __ATOMIC_RELAXED, __HIP_MEMORY_SCOPE_AGENT); }
__device__ __forceinline__ unsigned xb_xcc_id() { return (unsigned)__builtin_amdgcn_s_getreg((3 << 11) | 20) & 0xFu; }
#define XB_SPIN(cond, bar) do { unsigned _sp = 0; while (cond) { __builtin_amdgcn_s_sleep(1); \
    if ((++_sp & 255u) == 0u) { if (xb_ld(&(bar)[XB_TMO])) break; if (_sp > XB_SPIN_CAP) { atomicAdd(&(bar)[XB_TMO], 1u); break; } } } } while (0)
struct XcdBarrier { unsigned* bar; unsigned x; volatile LAS unsigned* st; };
__device__ __forceinline__ XcdBarrier xcd_barrier_post(unsigned* bar, volatile LAS unsigned* st) {
    XcdBarrier b; b.bar = bar; b.x = xb_xcc_id(); b.st = st;
    if (threadIdx.x == 0) (void)xb_add(&bar[XB_XCNT(b.x)], 1u);
    return b;
}
__device__ __forceinline__ void xcd_barrier_complete(unsigned* bar, unsigned x, unsigned& nloc, unsigned& nx) {
    const unsigned G = gridDim.x * gridDim.y * gridDim.z;
    unsigned sum, cnt, mine, sp = 0u;
    for (;;) {
        sum = 0u; cnt = 0u; mine = 0u;
#pragma unroll
        for (unsigned j = 0; j < 16; ++j) { const unsigned c = xb_ld(&bar[XB_XCNT(j)]); sum += c; cnt += (c > 0u) ? 1u : 0u; mine = (j == x) ? c : mine; }
        if (sum == G) break;
        __builtin_amdgcn_s_sleep(1);
        if ((++sp & 255u) == 0u) { if (xb_ld(&bar[XB_TMO])) break; if (sp > XB_SPIN_CAP) { atomicAdd(&bar[XB_TMO], 1u); break; } }
    }
    nloc = mine > 0u ? mine : 1u; nx = cnt > 0u ? cnt : 1u;
}
__device__ __forceinline__ void xcd_barrier(const XcdBarrier& b) {
    asm volatile("s_waitcnt vmcnt(0)" ::: "memory");
    __syncthreads();
    if (threadIdx.x == 0) {
        unsigned* bar = b.bar;
        __builtin_amdgcn_s_waitcnt(0);
        unsigned nloc = b.st[0], nx = b.st[1];
        if (nloc == 0u) { xcd_barrier_complete(bar, b.x, nloc, nx); b.st[0] = nloc; b.st[1] = nx; }
        const unsigned old = xb_add(&bar[XB_XSUB(b.x)], 1u);
        const unsigned gen = old / nloc;
        if (old + 1u == (gen + 1u) * nloc) {
            __builtin_amdgcn_fence(__ATOMIC_RELEASE, "agent");
            asm volatile("s_waitcnt vmcnt(0)" ::: "memory");
            const unsigned og = xb_add(&bar[XB_TOP], 1u);
            const unsigned tg = og / nx;
            if (og + 1u == (tg + 1u) * nx) xb_add(&bar[XB_TOPGEN], 1u);
            else XB_SPIN(xb_ld(&bar[XB_TOPGEN]) == tg, bar);
            __builtin_amdgcn_fence(__ATOMIC_ACQUIRE, "agent");
            xb_add(&bar[XB_XGEN(b.x)], 1u);
            asm volatile("s_waitcnt vmcnt(0)" ::: "memory");
        } else {
            XB_SPIN(xb_ld(&bar[XB_XGEN(b.x)]) == gen, bar);
            __builtin_amdgcn_fence(__ATOMIC_ACQUIRE, "agent");
            asm volatile("s_waitcnt vmcnt(0)" ::: "memory");
        }
    }
    __syncthreads();
}

__global__ void __launch_bounds__(512, 2) fwd_megakernel(Params p) {
    extern __shared__ __attribute__((aligned(16))) unsigned char smem[];
    LAS unsigned char* lds = (LAS unsigned char*)smem;
    cg::grid_group grid = cg::this_grid();
    unsigned* barw = (unsigned*)(opq(p.ws) + WS_BAR);
    volatile LAS unsigned* bst = (volatile LAS unsigned*)(lds + LDS_BYTES - 64);
    if (blockIdx.x == 0) for (int i = threadIdx.x; i < XCD_BAR_WORDS; i += 512) barw[i] = 0u;
    if (threadIdx.x < 2) bst[threadIdx.x] = 0u;
#ifndef NO_PRO
    prologue(p, lds);
#endif
    grid.sync();
    const XcdBarrier xbar = xcd_barrier_post(barw, bst);
#define GSYNC() xcd_barrier(xbar)
    const bf16_t* H = (const bf16_t*)(opq(p.ws) + WS_H);
    bf16_t* PROJ = (bf16_t*)(opq(p.ws) + WS_PROJ);
    const bf16_t* GATED = (const bf16_t*)(opq(p.ws) + WS_GATED);
    float* XS = (float*)(opq(p.ws) + WS_XS);
    for (int l = 0; l < 4; ++l) {
        const int j = l >> 1; const bool isna = (l & 1) != 0;
        norm_phase(p, l);
        GSYNC();
        {
            const int N = isna ? NP_NA : NP_RET;
            const bf16_t* Bt = (const bf16_t*)(opq(p.ws) + (isna ? (j ? WS_WNI1 : WS_WNI0) : (j ? WS_WRI1 : WS_WRI0)));
            pg8::Gemm gm{H, Bt, MT, N, DM, DM}; pg8::StaticOrder S; S.init(MT, N, (int)gridDim.x, (int)blockIdx.x);
            pg8::EpiBf16 E{PROJ, N};
#ifndef NO_G1
            pg8::gemm_phase<pg8::EpiBf16, pg8::StaticOrder>(lds, gm, S, E);
#endif
        }
        GSYNC();
#ifndef NO_RETA
        if (!isna) { ret_phaseA(p, j, lds); GSYNC(); ret_phaseB(p); }
#endif
#ifndef NO_NA
        if (isna) na_phase(p, j, l != 3, lds);
#endif
        GSYNC();
        {
            const bf16_t* Bt = (const bf16_t*)(opq(p.ws) + (isna ? (j ? WS_WNO1 : WS_WNO0) : (j ? WS_WRO1 : WS_WRO0)));
            {
                pg8::Gemm gm{GATED, Bt, ML, DM, EB, EB}; pg8::StaticOrder S; S.init(ML, DM, (int)gridDim.x, (int)blockIdx.x);
                pg8::EpiResid E{(l == 0) ? (const float*)opq(p.x) : (const float*)XS, XS, (const float*)(opq(p.ws) + WS_MODV) + (size_t)l * 5 * 6144 + 4096};
                pg8::gemm_phase<pg8::EpiResid, pg8::StaticOrder>(lds, gm, S, E);
            }
            if (l != 3) {
                pg8::Gemm gm{GATED + (size_t)ML * EB, Bt, MC, DM, EB / 8, EB}; pg8::SplitOrder S; S.init(MC, DM, 8, (int)gridDim.x, (int)blockIdx.x);
                pg8::EpiPartial E{(float*)(opq(p.ws) + WS_PART), MC, DM};
                pg8::gemm_phase<pg8::EpiPartial, pg8::SplitOrder>(lds, gm, S, E);
            }
        }
        GSYNC();
    }
    final_norm(p);
}

extern "C" void kernel_launch(void* const* d_in, const int* in_sizes, int n_in, void* d_out, int out_size, void* d_ws, size_t ws_size, hipStream_t stream) {
    static int grid_blocks = 0;
    if (grid_blocks == 0) {
        if (ws_size < WS_END) { fprintf(stderr, "kernel_launch: workspace too small (%zu < %zu)\n", ws_size, (size_t)WS_END); grid_blocks = -1; return; }
        int dev = 0, cus = 0, per_cu = 0;
        hipGetDevice(&dev);
        hipDeviceGetAttribute(&cus, hipDeviceAttributeMultiprocessorCount, dev);
        if (hipFuncSetAttribute((const void*)fwd_megakernel, hipFuncAttributeMaxDynamicSharedMemorySize, LDS_BYTES) != hipSuccess) { fprintf(stderr, "kernel_launch: hipFuncSetAttribute failed\n"); }
        if (hipOccupancyMaxActiveBlocksPerMultiprocessor(&per_cu, (const void*)fwd_megakernel, 512, LDS_BYTES) != hipSuccess || per_cu < 1) { fprintf(stderr, "kernel_launch: occupancy query says %d\n", per_cu); per_cu = 1; }
        (void)hipGetLastError();
        grid_blocks = cus * 1;
        if (grid_blocks <= 0) grid_blocks = 256;
    }
    if (grid_blocks < 0) return;
    Params p{};
    p.x = (const float*)d_in[0]; p.c = (const float*)d_in[1]; p.ctx = (const float*)d_in[2]; p.c_ctx = (const float*)d_in[3];
    p.mod_w = (const float*)d_in[4]; p.mod_b = (const float*)d_in[5]; p.norm_g = (const float*)d_in[6]; p.ret_w_in = (const float*)d_in[7];
    p.ret_df = (const float*)d_in[8]; p.ret_db = (const float*)d_in[9]; p.ret_w_out = (const float*)d_in[10]; p.na_w_in = (const float*)d_in[11];
    p.na_rpb = (const float*)d_in[12]; p.na_w_out = (const float*)d_in[13]; p.final_g = (const float*)d_in[14];
    p.out = (float*)d_out; p.ws = (unsigned char*)d_ws;
    void* args[] = {&p};
    hipError_t e = hipLaunchCooperativeKernel((const void*)fwd_megakernel, dim3(grid_blocks), dim3(512), args, LDS_BYTES, stream);
    if (e != hipSuccess) fprintf(stderr, "cooperative launch failed: %s (grid %d)\n", hipGetErrorString(e), grid_blocks);
}
```

```cpp
#include <hip/hip_runtime.h>
#include <hip/hip_cooperative_groups.h>
#include <cstdio>
namespace cg = cooperative_groups;

#define LAS __attribute__((address_space(3)))
typedef unsigned short bf16_t;
typedef short bf16x8 __attribute__((ext_vector_type(8)));
typedef short s16x4 __attribute__((ext_vector_type(4)));
typedef float f32x4 __attribute__((ext_vector_type(4)));
typedef float f32x2 __attribute__((ext_vector_type(2)));
typedef unsigned u32x4 __attribute__((ext_vector_type(4)));
typedef unsigned u32x2 __attribute__((ext_vector_type(2)));

constexpr int DM = 2048, NB = 4, SEQ = 2048, CTXL = 256, EB = 4096;
constexpr int ML = NB * SEQ, MC = NB * CTXL, MT = ML + MC;
constexpr int NP_RET = 12288, NP_NA = 16384;
constexpr float EPS = 1e-6f;

constexpr size_t MiB = 1u << 20;
constexpr size_t WS_WRI0 = 0, WS_WRI1 = 48 * MiB, WS_WNI0 = 96 * MiB, WS_WNI1 = 160 * MiB;
constexpr size_t WS_WRO0 = 224 * MiB, WS_WRO1 = 240 * MiB, WS_WNO0 = 256 * MiB, WS_WNO1 = 272 * MiB;
constexpr size_t WS_MODV = 288 * MiB, WS_ROPE = 289 * MiB, WS_XS = 290 * MiB, WS_H = 362 * MiB;
constexpr size_t WS_PROJ = 398 * MiB, WS_GATED = 686 * MiB, WS_OFB = 758 * MiB, WS_PART = 902 * MiB, WS_BAR = 966 * MiB, WS_END = 967 * MiB;

constexpr int LDS_BYTES = 147456;

struct Params {
    const float *x, *c, *ctx, *c_ctx, *mod_w, *mod_b, *norm_g, *ret_w_in, *ret_df, *ret_db, *ret_w_out, *na_w_in, *na_rpb, *na_w_out, *final_g;
    float* out; unsigned char* ws;
};

__device__ __forceinline__ unsigned cvt_pk_bf16(float lo, float hi) { unsigned r; asm volatile("v_cvt_pk_bf16_f32 %0, %1, %2" : "=v"(r) : "v"(lo), "v"(hi)); return r; }
__device__ __forceinline__ float bf_lo(unsigned u) { return __uint_as_float(u << 16); }
__device__ __forceinline__ float bf_hi(unsigned u) { return __uint_as_float(u & 0xffff0000u); }
__device__ __forceinline__ float wave_sum(float v) {
#define WS_DPP(ctrl) v += __builtin_bit_cast(float, __builtin_amdgcn_update_dpp(0, __builtin_bit_cast(int, v), (ctrl), 0xf, 0xf, false))
    WS_DPP(0x128); WS_DPP(0x124); WS_DPP(0x122); WS_DPP(0x121);
#undef WS_DPP
    const int vi = __builtin_bit_cast(int, v);
    const float r0 = __builtin_bit_cast(float, __builtin_amdgcn_readlane(vi, 0)), r1 = __builtin_bit_cast(float, __builtin_amdgcn_readlane(vi, 16));
    const float r2 = __builtin_bit_cast(float, __builtin_amdgcn_readlane(vi, 32)), r3 = __builtin_bit_cast(float, __builtin_amdgcn_readlane(vi, 48));
    return (r0 + r1) + (r2 + r3);
}
__device__ __forceinline__ int opaque_tid() { int t = threadIdx.x; asm volatile("" : "+v"(t)); return t; }
template <class T> __device__ __forceinline__ T* opq(T* q) { __attribute__((address_space(1))) T* g = (__attribute__((address_space(1))) T*)q; asm volatile("" : "+s"(g)); return (T*)g; }
__device__ __forceinline__ float silu_f(float v) { return v / (1.0f + __expf(-v)); }
__device__ __forceinline__ s16x4 tr_read(LAS unsigned char* p) {
    typedef short v4i16_t __attribute__((ext_vector_type(4)));
    return __builtin_bit_cast(s16x4, __builtin_amdgcn_ds_read_tr16_b64_v4i16((LAS v4i16_t*)p));
}
__device__ __forceinline__ bf16x8 cat8(s16x4 lo, s16x4 hi) { const u32x2 a = __builtin_bit_cast(u32x2, lo), b = __builtin_bit_cast(u32x2, hi); u32x4 r; r.x = a.x; r.y = a.y; r.z = b.x; r.w = b.y; return __builtin_bit_cast(bf16x8, r); }
__device__ __forceinline__ bf16x8 pack8(f32x4 a, f32x4 b) {
    u32x4 w; w.x = cvt_pk_bf16(a[0], a[1]); w.y = cvt_pk_bf16(a[2], a[3]); w.z = cvt_pk_bf16(b[0], b[1]); w.w = cvt_pk_bf16(b[2], b[3]);
    return __builtin_bit_cast(bf16x8, w);
}

namespace pg8 {
constexpr int BM = 256, BK = 64, HALF = 128, HTB = HALF * BK * 2, STAGE_BYTES = 8 * HTB, NXCD = 8, WGM = 8;
__host__ __device__ __forceinline__ int lds_byte(int r, int c) { const int st = (r >> 4) * 2 + (c >> 5), rr = r & 15, cc = c & 31, ob = rr * 64 + cc * 2; return st * 1024 + (ob ^ (((ob >> 9) & 1) << 5)); }
__host__ __device__ __forceinline__ void stage_rc(int b, int& R, int& C) { const int st = b / 1024, sb = b % 1024, swz = sb ^ (((sb >> 9) & 1) << 5); R = (st >> 1) * 16 + swz / 64; C = (st & 1) * 32 + (swz % 64) / 2; }
__host__ __device__ __forceinline__ int perm32(int rho) { const int n = rho >> 4, i = rho & 15; return 8 * (i >> 2) + 4 * n + (i & 3); }

struct Unit { int pm, pn, ks; };
struct Gemm { const bf16_t* A; const bf16_t* Bt; int M, N, K, ld; };

struct StaticOrder {
    int nM, nN, nwg, G, c;
    __device__ void init(int M, int N, int G_, int c_) { nM = M / BM; nN = N / BM; nwg = nM * nN; G = G_; c = c_; }
    __device__ bool next(int i, Unit& u) const {
        const long L = (long)i * G + c; if (L >= nwg) return false;
        int wgid = (int)L; { const int q = nwg / NXCD, r = nwg % NXCD, xcd = wgid % NXCD, off = wgid / NXCD; wgid = (xcd < r ? xcd * (q + 1) : r * (q + 1) + (xcd - r) * q) + off; }
        const int nig = WGM * nN, gid = wgid / nig, fm = gid * WGM, gsz = (nM - fm) < WGM ? (nM - fm) : WGM;
        u.pm = fm + ((wgid % nig) % gsz); u.pn = (wgid % nig) / gsz; u.ks = 0; return true;
    }
    __device__ __forceinline__ void a_ready(const Unit&) const {}
    __device__ __forceinline__ void done(const Unit&) const {}
};

struct SplitOrder {
    int nM, nN, nS, nwg, G, c;
    __device__ void init(int M, int N, int nS_, int G_, int c_) { nM = M / BM; nN = N / BM; nS = nS_; nwg = nM * nN * nS; G = G_; c = c_; }
    __device__ bool next(int i, Unit& u) const {
        const long L = (long)i * G + c; if (L >= nwg) return false;
        const int l = (int)L; u.ks = l % nS; const int t = l / nS; u.pm = t % nM; u.pn = t / nM; return true;
    }
    __device__ __forceinline__ void a_ready(const Unit&) const {}
    __device__ __forceinline__ void done(const Unit&) const {}
};
struct EpiPartial {
    static constexpr bool PERM = false;
    float* P; int rows, ldc;
    __device__ __forceinline__ void operator()(const f32x4 (&acc)[2][2][4][2], const Unit& u, int wr, int wc, int fr, int fq) const {
        const int row0 = u.pm * BM + wr * 64 + fr, col0 = u.pn * BM + wc * 32 + 4 * fq;
        float* base = P + (size_t)u.ks * rows * ldc;
#pragma unroll
        for (int ai = 0; ai < 2; ++ai)
#pragma unroll
            for (int m = 0; m < 4; ++m) { float* rowp = base + (size_t)(row0 + ai * HALF + m * 16) * ldc + col0;
#pragma unroll
                for (int bj = 0; bj < 2; ++bj)
#pragma unroll
                    for (int n = 0; n < 2; ++n) *(f32x4*)(rowp + bj * HALF + n * 16) = acc[ai][bj][m][n]; }
    }
};
struct EpiBf16 {
    static constexpr bool PERM = true;
    bf16_t* O; int ldc;
    __device__ __forceinline__ void operator()(const f32x4 (&acc)[2][2][4][2], const Unit& u, int wr, int wc, int fr, int fq) const {
        const int row0 = u.pm * BM + wr * 64 + fr; const int col0 = u.pn * BM + wc * 32 + 8 * fq;
#pragma unroll
        for (int ai = 0; ai < 2; ++ai)
#pragma unroll
            for (int m = 0; m < 4; ++m) { bf16_t* rowp = O + (size_t)(row0 + ai * HALF + m * 16) * ldc + col0;
#pragma unroll
                for (int bj = 0; bj < 2; ++bj) { const f32x4 v0 = acc[ai][bj][m][0], v1 = acc[ai][bj][m][1];
                    u32x4 w; w.x = cvt_pk_bf16(v0[0], v0[1]); w.y = cvt_pk_bf16(v0[2], v0[3]); w.z = cvt_pk_bf16(v1[0], v1[1]); w.w = cvt_pk_bf16(v1[2], v1[3]);
                    *(u32x4*)(rowp + bj * HALF) = w; } }
    }
};
struct EpiResid {
    static constexpr bool PERM = false;
    const float* xsrc; float* xout; const float* gt_base;
    __device__ __forceinline__ void operator()(const f32x4 (&acc)[2][2][4][2], const Unit& u, int wr, int wc, int fr, int fq) const {
        const int row0 = u.pm * BM + wr * 64 + fr, col0 = u.pn * BM + wc * 32 + 4 * fq;
        const int mrow = (u.pm * BM < ML) ? ((u.pm * BM) >> 11) : 4;
        const float* gt = gt_base + mrow * 6144;
        f32x4 gv[2][2];
#pragma unroll
        for (int bj = 0; bj < 2; ++bj)
#pragma unroll
            for (int n = 0; n < 2; ++n) gv[bj][n] = *(const f32x4*)(gt + col0 + bj * HALF + n * 16);
#pragma unroll
        for (int ai = 0; ai < 2; ++ai) {
            f32x4 xv[4][2][2];
#pragma unroll
            for (int m = 0; m < 4; ++m) { const float* sp = xsrc + (size_t)(row0 + ai * HALF + m * 16) * DM;
#pragma unroll
                for (int bj = 0; bj < 2; ++bj)
#pragma unroll
                    for (int n = 0; n < 2; ++n) xv[m][bj][n] = *(const f32x4*)(sp + col0 + bj * HALF + n * 16); }
#pragma unroll
            for (int m = 0; m < 4; ++m) { float* dp = xout + (size_t)(row0 + ai * HALF + m * 16) * DM;
#pragma unroll
                for (int bj = 0; bj < 2; ++bj)
#pragma unroll
                    for (int n = 0; n < 2; ++n) *(f32x4*)(dp + col0 + bj * HALF + n * 16) = xv[m][bj][n] + gv[bj][n] * acc[ai][bj][m][n]; }
        }
    }
};

template <class Epi, class Sched, bool ALIGN_EPI = true, bool SP2 = true>
__device__ __forceinline__ void gemm_phase(LAS unsigned char* lds, const Gemm g, const Sched& S, const Epi& E) {
    const int tid = opaque_tid(), wid = __builtin_amdgcn_readfirstlane(tid >> 6), lane = tid & 63, wr = wid >> 2, wc = wid & 3, fr = lane & 15, fq = lane >> 4;
    const int K = g.ld, nt = g.K / BK;
    unsigned voffA[2], voffB[2];
#pragma unroll
    for (int i = 0; i < 2; ++i) { int R, C; stage_rc(tid * 16 + i * 8192, R, C); const int Rb = Epi::PERM ? ((R & ~31) + perm32(R & 31)) : R;
        voffA[i] = (unsigned)(R * K + C) * 2u; voffB[i] = (unsigned)(Rb * K + C) * 2u; }
    const size_t kstep = (size_t)(BK * 2);
    const size_t hstep = (size_t)HALF * K * 2;
    const size_t tstep = 2 * hstep;
    const unsigned ldsw = (unsigned)wid * 1024u;
    const int aoff = lds_byte(wr * 64 + fr, fq * 8), boff = lds_byte(wc * 32 + fr, fq * 8);
#define PG8_SA(b, h) (((b) * 2 + (h)) * HTB)
#define PG8_SB(b, h) ((4 + (b) * 2 + (h)) * HTB)
#define PG8_STAGE(bufoff, gbase, voff) do { _Pragma("unroll") for (int _i = 0; _i < 2; ++_i) \
        __builtin_amdgcn_global_load_lds((const unsigned*)((const char*)(gbase) + (voff)[_i]), (LAS unsigned*)(lds + (bufoff) + ldsw + _i * 8192), 16, 0, 0); } while (0)
#define PG8_LDA(dst, b, h) do { _Pragma("unroll") for (int m = 0; m < 4; ++m) _Pragma("unroll") for (int k = 0; k < 2; ++k) dst[m][k] = *(const LAS bf16x8*)(lds + PG8_SA(b, h) + aoff + m * 2048 + k * 1024); } while (0)
#define PG8_LDB(dst, b, h) do { _Pragma("unroll") for (int n = 0; n < 2; ++n) _Pragma("unroll") for (int k = 0; k < 2; ++k) dst[n][k] = *(const LAS bf16x8*)(lds + PG8_SB(b, h) + boff + n * 2048 + k * 1024); } while (0)
#define PG8_MMA(ai, bj, At, Bt) do { __builtin_amdgcn_s_setprio(1); _Pragma("unroll") for (int m = 0; m < 4; ++m) _Pragma("unroll") for (int n = 0; n < 2; ++n) _Pragma("unroll") for (int k = 0; k < 2; ++k) \
        acc[ai][bj][m][n] = __builtin_amdgcn_mfma_f32_16x16x32_bf16(Bt[n][k], At[m][k], acc[ai][bj][m][n], 0, 0, 0); __builtin_amdgcn_s_setprio(0); } while (0)
#define PG8_WAIT_V(n) asm volatile("s_waitcnt vmcnt(" #n ")" ::: "memory")
#define PG8_WAIT_L(n) asm volatile("s_waitcnt lgkmcnt(" #n ")" ::: "memory")
#define PG8_BAR __builtin_amdgcn_s_barrier()
#define PG8_SCHED __builtin_amdgcn_sched_barrier(0)
    Unit cur, nxt; int ui = 0;
    if (!S.next(0, cur)) return;
    f32x4 acc[2][2][4][2];
#pragma unroll
    for (int a = 0; a < 2; ++a)
#pragma unroll
        for (int b = 0; b < 2; ++b)
#pragma unroll
            for (int m = 0; m < 4; ++m)
#pragma unroll
                for (int n = 0; n < 2; ++n) acc[a][b][m][n] = (f32x4){0.f, 0.f, 0.f, 0.f};
    bf16x8 At[4][2], B0[2][2], B1[2][2];
    const size_t ksb = (size_t)g.K * 2;
    const char* cA = (const char*)g.A + (size_t)cur.pm * tstep + cur.ks * ksb; const char* cB = (const char*)g.Bt + (size_t)cur.pn * tstep + cur.ks * ksb;
    S.a_ready(cur);
    if constexpr (SP2) {
        PG8_STAGE(PG8_SB(0, 0), cB, voffB); PG8_STAGE(PG8_SB(0, 1), cB + hstep, voffB); PG8_STAGE(PG8_SA(0, 0), cA, voffA); PG8_STAGE(PG8_SA(0, 1), cA + hstep, voffA);
        if (wr == 1) PG8_BAR;
        PG8_WAIT_V(2); PG8_BAR;
        PG8_STAGE(PG8_SB(1, 0), cB + kstep, voffB); PG8_STAGE(PG8_SA(1, 0), cA + kstep, voffA); PG8_STAGE(PG8_SB(1, 1), cB + hstep + kstep, voffB);
        PG8_WAIT_V(6); PG8_BAR;
    } else {
        PG8_STAGE(PG8_SB(0, 0), cB, voffB); PG8_STAGE(PG8_SA(0, 0), cA, voffA); PG8_STAGE(PG8_SB(0, 1), cB + hstep, voffB); PG8_STAGE(PG8_SA(0, 1), cA + hstep, voffA);
        if (wr == 1) PG8_BAR;
        PG8_WAIT_V(4); PG8_BAR;
        PG8_STAGE(PG8_SB(1, 0), cB + kstep, voffB); PG8_STAGE(PG8_SA(1, 0), cA + kstep, voffA); PG8_STAGE(PG8_SB(1, 1), cB + hstep + kstep, voffB);
        PG8_WAIT_V(6); PG8_BAR;
    }
    for (;;) {
        const bool has_next = S.next(ui + 1, nxt);
        const char* nA = has_next ? (const char*)g.A + (size_t)nxt.pm * tstep + nxt.ks * ksb : cA; const char* nB = has_next ? (const char*)g.Bt + (size_t)nxt.pn * tstep + nxt.ks * ksb : cB;
        for (int t = 0; t < nt; t += 2) {
            const bool last = (t == nt - 2);
            const char* a1 = cA + (size_t)(t + 1) * kstep;
            const char* a2 = last ? nA : cA + (size_t)(t + 2) * kstep; const char* b2 = last ? nB : cB + (size_t)(t + 2) * kstep;
            const char* a3 = a2 + kstep; const char* b3 = b2 + kstep;
            if (last && has_next) S.a_ready(nxt);
            if constexpr (SP2) {
            PG8_LDB(B0, 0, 0); PG8_LDB(B1, 0, 1); PG8_SCHED; PG8_LDA(At, 0, 0); PG8_STAGE(PG8_SA(1, 1), a1 + hstep, voffA);
            PG8_WAIT_V(8); PG8_WAIT_L(0); PG8_BAR; PG8_MMA(0, 0, At, B0); PG8_MMA(0, 1, At, B1); PG8_BAR; PG8_SCHED;
            PG8_LDA(At, 0, 1); PG8_STAGE(PG8_SB(0, 0), b2, voffB); PG8_STAGE(PG8_SB(0, 1), b2 + hstep, voffB); PG8_STAGE(PG8_SA(0, 0), a2, voffA);
            PG8_WAIT_V(8); PG8_WAIT_L(0); PG8_BAR; PG8_MMA(1, 0, At, B0); PG8_MMA(1, 1, At, B1); PG8_BAR; PG8_SCHED;
            PG8_LDB(B0, 1, 0); PG8_LDB(B1, 1, 1); PG8_SCHED; PG8_LDA(At, 1, 0); PG8_STAGE(PG8_SA(0, 1), a2 + hstep, voffA);
            PG8_WAIT_V(8); PG8_WAIT_L(0); PG8_BAR; PG8_MMA(0, 0, At, B0); PG8_MMA(0, 1, At, B1); PG8_BAR; PG8_SCHED;
            PG8_LDA(At, 1, 1); PG8_STAGE(PG8_SB(1, 0), b3, voffB); PG8_STAGE(PG8_SB(1, 1), b3 + hstep, voffB); PG8_STAGE(PG8_SA(1, 0), a3, voffA);
            PG8_WAIT_V(8); PG8_WAIT_L(0); PG8_BAR; PG8_MMA(1, 0, At, B0); PG8_MMA(1, 1, At, B1); PG8_BAR; PG8_SCHED;
            } else {
            PG8_LDB(B0, 0, 0); PG8_SCHED; PG8_LDA(At, 0, 0); PG8_STAGE(PG8_SA(1, 1), a1 + hstep, voffA);
            PG8_WAIT_L(8); PG8_BAR; PG8_WAIT_L(0); PG8_MMA(0, 0, At, B0); PG8_BAR; PG8_SCHED;
            PG8_LDB(B1, 0, 1); PG8_STAGE(PG8_SB(0, 0), b2, voffB);
            PG8_BAR; PG8_WAIT_L(0); PG8_MMA(0, 1, At, B1); PG8_BAR;
            PG8_LDA(At, 0, 1); PG8_STAGE(PG8_SA(0, 0), a2, voffA);
            PG8_BAR; PG8_WAIT_L(0); PG8_MMA(1, 0, At, B0); PG8_BAR; PG8_SCHED;
            PG8_STAGE(PG8_SB(0, 1), b2 + hstep, voffB);
            PG8_WAIT_V(6); PG8_BAR; PG8_MMA(1, 1, At, B1); PG8_BAR;
            PG8_LDB(B0, 1, 0); PG8_SCHED; PG8_LDA(At, 1, 0); PG8_STAGE(PG8_SA(0, 1), a2 + hstep, voffA);
            PG8_WAIT_L(8); PG8_BAR; PG8_WAIT_L(0); PG8_MMA(0, 0, At, B0); PG8_BAR; PG8_SCHED;
            PG8_LDB(B1, 1, 1); PG8_STAGE(PG8_SB(1, 0), b3, voffB);
            PG8_BAR; PG8_WAIT_L(0); PG8_MMA(0, 1, At, B1); PG8_BAR;
            PG8_LDA(At, 1, 1); PG8_STAGE(PG8_SA(1, 0), a3, voffA);
            PG8_BAR; PG8_WAIT_L(0); PG8_MMA(1, 0, At, B0); PG8_BAR; PG8_SCHED;
            PG8_STAGE(PG8_SB(1, 1), b3 + hstep, voffB);
            PG8_WAIT_V(6); PG8_BAR; PG8_MMA(1, 1, At, B1); PG8_BAR;
            }
        }
        if constexpr (ALIGN_EPI) { if (wr == 0) PG8_BAR; }
        E(acc, cur, wr, wc, fr, fq); S.done(cur);
        if (!has_next) break;
#pragma unroll
        for (int a = 0; a < 2; ++a)
#pragma unroll
            for (int b = 0; b < 2; ++b)
#pragma unroll
                for (int m = 0; m < 4; ++m)
#pragma unroll
                    for (int n = 0; n < 2; ++n) acc[a][b][m][n] = (f32x4){0.f, 0.f, 0.f, 0.f};
        cur = nxt; cA = nA; cB = nB; ++ui;
        if constexpr (ALIGN_EPI) { if (wr == 1) PG8_BAR; }
    }
    PG8_WAIT_V(0);
    if constexpr (!ALIGN_EPI) { if (wr == 0) PG8_BAR; }
    PG8_BAR;
#undef PG8_SA
#undef PG8_SB
#undef PG8_STAGE
#undef PG8_LDA
#undef PG8_LDB
#undef PG8_MMA
#undef PG8_WAIT_V
#undef PG8_WAIT_L
#undef PG8_BAR
#undef PG8_SCHED
}
}

__device__ __forceinline__ void transpose_item(const float* W, int K, int N, bf16_t* WT, LAS float* scr, int item, int lane) {
    const int nblk = N >> 6, kb = item / nblk, nb = item - kb * nblk, k0 = kb * 64, n0 = nb * 64;
    const float* src = W + (size_t)k0 * N + n0 + lane;
#pragma unroll 16
    for (int i = 0; i < 64; ++i) scr[i * 65 + lane] = __builtin_nontemporal_load(src + (size_t)i * N);
    asm volatile("s_waitcnt lgkmcnt(0)" ::: "memory");
    const int c = lane & 7;
#pragma unroll
    for (int j = 0; j < 8; ++j) { const int n = (lane >> 3) + 8 * j; const LAS float* s = scr + (8 * c) * 65 + n;
        u32x4 o; o.x = cvt_pk_bf16(s[0], s[65]); o.y = cvt_pk_bf16(s[2 * 65], s[3 * 65]); o.z = cvt_pk_bf16(s[4 * 65], s[5 * 65]); o.w = cvt_pk_bf16(s[6 * 65], s[7 * 65]);
        *(u32x4*)(WT + (size_t)(n0 + n) * K + k0 + 8 * c) = o; }
    asm volatile("s_waitcnt lgkmcnt(0)" ::: "memory");
}

__device__ __forceinline__ void prologue(const Params& p, LAS unsigned char* lds) {
    unsigned char* ws_ = opq(p.ws);
    const int tid = opaque_tid(), lane = tid & 63, wave = tid >> 6;
    LAS float* cs = (LAS float*)lds;
    LAS float* red = (LAS float*)(lds + 40960);
    for (int i = tid; i < 5 * DM; i += 512) { const float v = (i < 4 * DM) ? opq(p.c)[i] : opq(p.c_ctx)[i - 4 * DM]; cs[i] = v / (1.0f + expf(-v)); }
    __syncthreads();
    float* modv = (float*)(ws_ + WS_MODV);
    for (int item = blockIdx.x; item < 384; item += gridDim.x) {
        const int l = item / 96, cgp = item - l * 96;
        const float* W = opq(p.mod_w) + (size_t)l * DM * 6144 + cgp * 64 + lane;
        float a0 = 0.f, a1 = 0.f, a2 = 0.f, a3 = 0.f, a4 = 0.f;
        const int k0 = wave * 256;
#pragma unroll 8
        for (int k = k0; k < k0 + 256; ++k) { const float w = __builtin_nontemporal_load(W + (size_t)k * 6144); a0 += cs[k] * w; a1 += cs[DM + k] * w; a2 += cs[2 * DM + k] * w; a3 += cs[3 * DM + k] * w; a4 += cs[4 * DM + k] * w; }
        red[(wave * 5 + 0) * 64 + lane] = a0; red[(wave * 5 + 1) * 64 + lane] = a1; red[(wave * 5 + 2) * 64 + lane] = a2; red[(wave * 5 + 3) * 64 + lane] = a3; red[(wave * 5 + 4) * 64 + lane] = a4;
        __syncthreads();
        if (tid < 320) { const int r = tid >> 6; float s = 0.f;
#pragma unroll
            for (int w = 0; w < 8; ++w) s += red[(w * 5 + r) * 64 + lane];
            modv[(size_t)(l * 5 + r) * 6144 + cgp * 64 + lane] = s + opq(p.mod_b)[l * 6144 + cgp * 64 + lane]; }
        __syncthreads();
    }
    {
        const int gt = blockIdx.x * 512 + tid;
        if (gt < 4096) { const int pos = gt >> 6, f = gt & 63; const float freq = exp2f(-(float)f * (13.287712379549449f / 64.0f)); const float ang = (float)pos * freq;
            float sn, cn; sincosf(ang, &sn, &cn); ((f32x2*)(ws_ + WS_ROPE))[gt] = (f32x2){cn, sn}; }
    }
    __syncthreads();
    LAS float* scr = (LAS float*)(lds + wave * 16640);
    const int gw = blockIdx.x * 8 + wave, NGW = gridDim.x * 8;
    constexpr int I_RI = 32 * 192, I_NI = 32 * 256, I_O = 64 * 32;
    constexpr int NITEMS = 2 * I_RI + 2 * I_NI + 4 * I_O;
    for (int it = gw; it < NITEMS; it += NGW) {
        int r = it;
        if (r < I_RI) { transpose_item(opq(p.ret_w_in), DM, NP_RET, (bf16_t*)(ws_ + WS_WRI0), scr, r, lane); continue; } r -= I_RI;
        if (r < I_O) { transpose_item(opq(p.ret_w_out), EB, DM, (bf16_t*)(ws_ + WS_WRO0), scr, r, lane); continue; } r -= I_O;
        if (r < I_NI) { transpose_item(opq(p.na_w_in), DM, NP_NA, (bf16_t*)(ws_ + WS_WNI0), scr, r, lane); continue; } r -= I_NI;
        if (r < I_O) { transpose_item(opq(p.na_w_out), EB, DM, (bf16_t*)(ws_ + WS_WNO0), scr, r, lane); continue; } r -= I_O;
        if (r < I_RI) { transpose_item(opq(p.ret_w_in) + (size_t)DM * NP_RET, DM, NP_RET, (bf16_t*)(ws_ + WS_WRI1), scr, r, lane); continue; } r -= I_RI;
        if (r < I_O) { transpose_item(opq(p.ret_w_out) + (size_t)EB * DM, EB, DM, (bf16_t*)(ws_ + WS_WRO1), scr, r, lane); continue; } r -= I_O;
        if (r < I_NI) { transpose_item(opq(p.na_w_in) + (size_t)DM * NP_NA, DM, NP_NA, (bf16_t*)(ws_ + WS_WNI1), scr, r, lane); continue; } r -= I_NI;
        transpose_item(opq(p.na_w_out) + (size_t)EB * DM, EB, DM, (bf16_t*)(ws_ + WS_WNO1), scr, r, lane);
    }
    __syncthreads();
}

__device__ __forceinline__ void norm_emit(const f32x4 (&v)[8], const f32x4 (&gs)[8], const f32x4 (&sh)[8], bf16_t* hrow, int lane) {
    float ss = 0.f;
#pragma unroll
    for (int j = 0; j < 8; ++j) ss += (v[j][0] * v[j][0] + v[j][1] * v[j][1]) + (v[j][2] * v[j][2] + v[j][3] * v[j][3]);
    ss = wave_sum(ss);
    const float rstd = 1.0f / sqrtf(ss * (1.0f / DM) + EPS);
    u32x2* o = (u32x2*)hrow;
#pragma unroll
    for (int j = 0; j < 8; ++j) { const f32x4 hv = v[j] * rstd * gs[j] + sh[j];
        u32x2 w; w.x = cvt_pk_bf16(hv[0], hv[1]); w.y = cvt_pk_bf16(hv[2], hv[3]); o[lane + 64 * j] = w; }
}
__device__ __forceinline__ void norm_phase(const Params& p, int l) {
    unsigned char* ws_ = opq(p.ws);
    const int tid = opaque_tid(), lane = tid & 63, wave = tid >> 6;
    const int gw = blockIdx.x * 8 + wave, NGW = gridDim.x * 8;
    float* XS = (float*)(ws_ + WS_XS);
    const float* modv = (const float*)(ws_ + WS_MODV);
    const float* PART = (const float*)(ws_ + WS_PART);
    bf16_t* H = (bf16_t*)(ws_ + WS_H);
    const f32x4* g4 = (const f32x4*)(opq(p.norm_g) + l * DM);
    f32x4 gg[8];
#pragma unroll
    for (int j = 0; j < 8; ++j) gg[j] = g4[lane + 64 * j];
    for (int m = ML + gw; m < MT; m += NGW) {
        const float* src = (l <= 1) ? opq(p.ctx) + (size_t)(m - ML) * DM : XS + (size_t)m * DM;
        const f32x4* sh4 = (const f32x4*)(modv + (size_t)(l * 5 + 4) * 6144);
        f32x4 v[8], gs[8], sh[8];
#pragma unroll
        for (int j = 0; j < 8; ++j) { v[j] = ((const f32x4*)src)[lane + 64 * j]; gs[j] = gg[j] * (sh4[DM / 4 + lane + 64 * j] + 1.0f); sh[j] = sh4[lane + 64 * j]; }
        if (l != 0) {
            const f32x4* gt4 = (const f32x4*)(modv + (size_t)((l - 1) * 5 + 4) * 6144 + 4096);
            const f32x4* pp = (const f32x4*)(PART + (size_t)(m - ML) * DM);
#pragma unroll
            for (int j = 0; j < 8; ++j) { f32x4 a = (f32x4){0.f, 0.f, 0.f, 0.f};
#pragma unroll
                for (int sp = 0; sp < 8; ++sp) a += pp[(size_t)sp * (MC * DM / 4) + lane + 64 * j];
                v[j] += gt4[lane + 64 * j] * a; }
#pragma unroll
            for (int j = 0; j < 8; ++j) ((f32x4*)(XS + (size_t)m * DM))[lane + 64 * j] = v[j];
        }
        norm_emit(v, gs, sh, H + (size_t)m * DM, lane);
    }
    const float* lsrc = (l == 0) ? opq(p.x) : (const float*)XS;
    int pstart = gw, pend = ML / 2, pstep = NGW;
    if (l > 0 && NGW == 2048) { if (gw < 1024) { pstart = gw; pend = gw + 1; } else { pstart = 1024 + (gw - 1024) * 3; pend = pstart + 3; } pstep = 1; }
    for (int pi = pstart; pi < pend; pi += pstep) {
        const int m0 = pi * 2;
        const f32x4* sh4 = (const f32x4*)(modv + (size_t)(l * 5 + (m0 >> 11)) * 6144);
        f32x4 va[8], vb[8], gs[8], sh[8];
#pragma unroll
        for (int j = 0; j < 8; ++j) { va[j] = ((const f32x4*)(lsrc + (size_t)m0 * DM))[lane + 64 * j]; vb[j] = ((const f32x4*)(lsrc + (size_t)(m0 + 1) * DM))[lane + 64 * j];
            gs[j] = gg[j] * (sh4[DM / 4 + lane + 64 * j] + 1.0f); sh[j] = sh4[lane + 64 * j]; }
        norm_emit(va, gs, sh, H + (size_t)m0 * DM, lane);
        norm_emit(vb, gs, sh, H + (size_t)(m0 + 1) * DM, lane);
    }
}
__device__ __forceinline__ void final_norm(const Params& p) {
    unsigned char* ws_ = opq(p.ws);
    const int tid = opaque_tid(), lane = tid & 63, wave = tid >> 6;
    const int gw = blockIdx.x * 8 + wave, NGW = gridDim.x * 8;
    const float* XS = (const float*)(ws_ + WS_XS);
    const f32x4* g4 = (const f32x4*)opq(p.final_g);
    float* outp = opq(p.out);
    f32x4 gg[8];
#pragma unroll
    for (int j = 0; j < 8; ++j) gg[j] = g4[lane + 64 * j];
    for (int m0 = gw * 2; m0 < ML; m0 += NGW * 2) {
        f32x4 v[2][8];
#pragma unroll
        for (int q = 0; q < 2; ++q)
#pragma unroll
            for (int j = 0; j < 8; ++j) v[q][j] = ((const f32x4*)(XS + (size_t)(m0 + q) * DM))[lane + 64 * j];
#pragma unroll
        for (int q = 0; q < 2; ++q) { float ss = 0.f;
#pragma unroll
            for (int j = 0; j < 8; ++j) ss += (v[q][j][0] * v[q][j][0] + v[q][j][1] * v[q][j][1]) + (v[q][j][2] * v[q][j][2] + v[q][j][3] * v[q][j][3]);
            ss = wave_sum(ss);
            const float rstd = 1.0f / sqrtf(ss * (1.0f / DM) + EPS);
            f32x4* o = (f32x4*)(outp + (size_t)(m0 + q) * DM);
#pragma unroll
            for (int j = 0; j < 8; ++j) o[lane + 64 * j] = v[q][j] * rstd * gg[j];
        }
    }
}

constexpr int RQ_STRIDE = 528, RK_STRIDE = 544, RV_STRIDE = 288, RP_STRIDE = 144;
constexpr int R_QS = 0, R_KS = 33792, R_VS = 68608, R_PS = 87040;
__device__ __forceinline__ void ret_phaseA(const Params& p, int j, LAS unsigned char* lds) {
    unsigned char* ws_ = opq(p.ws);
    const int tid = opaque_tid(), lane = tid & 63, w = __builtin_amdgcn_readfirstlane(tid >> 6), g = lane >> 4, li = lane & 15;
    const int tq = li >> 2, tp = li & 3;
    const bf16_t* PROJ = (const bf16_t*)(ws_ + WS_PROJ);
    bf16_t* OFB = (bf16_t*)(ws_ + WS_OFB);
    const f32x2* rope = (const f32x2*)(ws_ + WS_ROPE);
    LAS unsigned char* Qs = lds + R_QS; LAS unsigned char* Ks = lds + R_KS; LAS unsigned char* Vs = lds + R_VS; LAS unsigned char* Ps = lds + R_PS;
    for (int u = blockIdx.x; u < 256; u += gridDim.x) {
        const int slice = (u >> 3) & 3, grp = (u & 7) | ((u >> 5) << 3), dir = grp & 1, h = (grp >> 1) & 7, b = grp >> 4;
        const float raw = (dir ? opq(p.ret_db) : opq(p.ret_df))[j * 8 + h];
        const float lg = -log1pf(expf(raw));
        const float cdec = expf(lg * 64.0f);
        f32x4 S[16];
#pragma unroll
        for (int i = 0; i < 16; ++i) S[i] = (f32x4){0.f, 0.f, 0.f, 0.f};
        u32x4 pq[2][2], pk[2][2], pv[2];
#define RET_ROWBASE(s, rb, cc, isctx) do { isctx = (s) < 4; const int ci_ = isctx ? (s) : (s) - 4; const int nch_ = isctx ? 4 : 32; cc = dir ? nch_ - 1 - ci_ : ci_; \
        rb = isctx ? ML + b * CTXL + cc * 64 : b * SEQ + cc * 64; } while (0)
#define RET_LOAD(s) do { int rb_, cc_; bool ic_; RET_ROWBASE(s, rb_, cc_, ic_); _Pragma("unroll") for (int t = 0; t < 2; ++t) { const int tk = tid + 512 * t; const int row = tk >> 4, sub = tk & 15; \
        const int d0 = (sub >> 3) * 128 + (sub & 7) * 8; const bf16_t* sp = PROJ + (size_t)(rb_ + row) * NP_RET + h * 256 + d0; \
        pq[t][0] = *(const u32x4*)sp; pq[t][1] = *(const u32x4*)(sp + 64); pk[t][0] = *(const u32x4*)(sp + 2048); pk[t][1] = *(const u32x4*)(sp + 2048 + 64); \
        pv[t] = *(const u32x4*)(PROJ + (size_t)(rb_ + row) * NP_RET + 4096 + h * 512 + slice * 128 + sub * 8); } } while (0)
        RET_LOAD(0);
        for (int s = 0; s < 36; ++s) {
            int rowbase, cc; bool isctx; RET_ROWBASE(s, rowbase, cc, isctx);
#pragma unroll
            for (int t = 0; t < 2; ++t) {
                const int tk = tid + 512 * t; const int row = tk >> 4, sub = tk & 15; const int half = sub >> 3, gq = sub & 7; const int d0 = half * 128 + gq * 8;
                const float e_i = dir ? (float)(64 - row) : (float)(row + 1);
                const float fqs = expf(lg * e_i), fks = expf(-lg * e_i) * 0.0625f;
                float q1[8], q2[8], k1[8], k2[8];
#pragma unroll
                for (int e = 0; e < 4; ++e) { q1[2 * e] = bf_lo(pq[t][0][e]); q1[2 * e + 1] = bf_hi(pq[t][0][e]); q2[2 * e] = bf_lo(pq[t][1][e]); q2[2 * e + 1] = bf_hi(pq[t][1][e]);
                    k1[2 * e] = bf_lo(pk[t][0][e]); k1[2 * e + 1] = bf_hi(pk[t][0][e]); k2[2 * e] = bf_lo(pk[t][1][e]); k2[2 * e + 1] = bf_hi(pk[t][1][e]); }
                if (!isctx) {
                    const int pos = half ? row : cc;
                    const f32x4* rp = (const f32x4*)(rope + pos * 64 + gq * 8);
#pragma unroll
                    for (int e = 0; e < 4; ++e) { const f32x4 cs2 = rp[e];
                        { const float c0 = cs2[0], s0 = cs2[1]; const float a = q1[2 * e], bb = q2[2 * e]; q1[2 * e] = a * c0 - bb * s0; q2[2 * e] = a * s0 + bb * c0;
                          const float ka = k1[2 * e], kb = k2[2 * e]; k1[2 * e] = ka * c0 - kb * s0; k2[2 * e] = ka * s0 + kb * c0; }
                        { const float c0 = cs2[2], s0 = cs2[3]; const float a = q1[2 * e + 1], bb = q2[2 * e + 1]; q1[2 * e + 1] = a * c0 - bb * s0; q2[2 * e + 1] = a * s0 + bb * c0;
                          const float ka = k1[2 * e + 1], kb = k2[2 * e + 1]; k1[2 * e + 1] = ka * c0 - kb * s0; k2[2 * e + 1] = ka * s0 + kb * c0; } }
                }
                u32x4 o;
                o.x = cvt_pk_bf16(q1[0] * fqs, q1[1] * fqs); o.y = cvt_pk_bf16(q1[2] * fqs, q1[3] * fqs); o.z = cvt_pk_bf16(q1[4] * fqs, q1[5] * fqs); o.w = cvt_pk_bf16(q1[6] * fqs, q1[7] * fqs);
                *(LAS u32x4*)(Qs + row * RQ_STRIDE + d0 * 2) = o;
                o.x = cvt_pk_bf16(q2[0] * fqs, q2[1] * fqs); o.y = cvt_pk_bf16(q2[2] * fqs, q2[3] * fqs); o.z = cvt_pk_bf16(q2[4] * fqs, q2[5] * fqs); o.w = cvt_pk_bf16(q2[6] * fqs, q2[7] * fqs);
                *(LAS u32x4*)(Qs + row * RQ_STRIDE + (d0 + 64) * 2) = o;
                o.x = cvt_pk_bf16(k1[0] * fks, k1[1] * fks); o.y = cvt_pk_bf16(k1[2] * fks, k1[3] * fks); o.z = cvt_pk_bf16(k1[4] * fks, k1[5] * fks); o.w = cvt_pk_bf16(k1[6] * fks, k1[7] * fks);
                *(LAS u32x4*)(Ks + row * RK_STRIDE + d0 * 2) = o;
                o.x = cvt_pk_bf16(k2[0] * fks, k2[1] * fks); o.y = cvt_pk_bf16(k2[2] * fks, k2[3] * fks); o.z = cvt_pk_bf16(k2[4] * fks, k2[5] * fks); o.w = cvt_pk_bf16(k2[6] * fks, k2[7] * fks);
                *(LAS u32x4*)(Ks + row * RK_STRIDE + (d0 + 64) * 2) = o;
                *(LAS u32x4*)(Vs + row * RV_STRIDE + sub * 16) = pv[t];
            }
            __syncthreads();
            if (s + 1 < 36) RET_LOAD(s + 1);
            {
                const int ib = w >> 1;
#pragma unroll
                for (int t = 0; t < 2; ++t) {
                    const int jb = 2 * (w & 1) + t;
                    f32x4 acc = (f32x4){0.f, 0.f, 0.f, 0.f};
                    const bool nz = dir ? (jb >= ib) : (jb <= ib);
                    if (nz) {
                        const LAS unsigned char* kp_ = Ks + (jb * 16 + li) * RK_STRIDE + (8 * g) * 2; const LAS unsigned char* qp_ = Qs + (ib * 16 + li) * RQ_STRIDE + (8 * g) * 2;
                        bf16x8 na_ = *(const LAS bf16x8*)kp_, nb_ = *(const LAS bf16x8*)qp_, na2_ = *(const LAS bf16x8*)(kp_ + 64), nb2_ = *(const LAS bf16x8*)(qp_ + 64);
#pragma unroll
                        for (int kk = 0; kk < 8; ++kk) {
                            const bf16x8 a = na_, bq = nb_; na_ = na2_; nb_ = nb2_;
                            if (kk + 2 < 8) { na2_ = *(const LAS bf16x8*)(kp_ + (kk + 2) * 64); nb2_ = *(const LAS bf16x8*)(qp_ + (kk + 2) * 64); }
                            acc = __builtin_amdgcn_mfma_f32_16x16x32_bf16(a, bq, acc, 0, 0, 0);
                            __builtin_amdgcn_sched_barrier(0);
                        }
                        const int i = ib * 16 + li;
#pragma unroll
                        for (int r = 0; r < 4; ++r) { const int jj = jb * 16 + 4 * g + r; const bool keep = dir ? (jj >= i) : (jj <= i); acc[r] = keep ? acc[r] : 0.f; }
                    }
                    u32x2 wv; wv.x = cvt_pk_bf16(acc[0], acc[1]); wv.y = cvt_pk_bf16(acc[2], acc[3]);
                    *(LAS u32x2*)(Ps + (ib * 16 + li) * RP_STRIDE + (jb * 16 + 4 * g) * 2) = wv;
                }
            }
            f32x4 oacc[4];
#pragma unroll
            for (int ib = 0; ib < 4; ++ib) oacc[ib] = (f32x4){0.f, 0.f, 0.f, 0.f};
            {
                const LAS unsigned char* qa0 = Qs + li * RQ_STRIDE + (4 * g) * 2;
#define RET_QF(idx) cat8(*(const LAS s16x4*)(qa0 + ((idx) & 3) * 16 * RQ_STRIDE + ((idx) >> 2) * 64), *(const LAS s16x4*)(qa0 + ((idx) & 3) * 16 * RQ_STRIDE + ((idx) >> 2) * 64 + 32))
                bf16x8 qn0 = RET_QF(0), qn1 = RET_QF(1), qn2 = RET_QF(2);
#pragma unroll
                for (int T = 0; T < 8; ++T) {
                    const bf16x8 bfrag = pack8(S[2 * T], S[2 * T + 1]);
#pragma unroll
                    for (int ib = 0; ib < 4; ++ib) {
                        const int idx = T * 4 + ib; const bf16x8 a = qn0; qn0 = qn1; qn1 = qn2;
                        if (idx + 3 < 32) qn2 = RET_QF(idx + 3);
                        oacc[ib] = __builtin_amdgcn_mfma_f32_16x16x32_bf16(a, bfrag, oacc[ib], 0, 0, 0);
                        __builtin_amdgcn_sched_barrier(0);
                    }
                }
#undef RET_QF
            }
            bf16x8 vfrag[2];
#pragma unroll
            for (int ks = 0; ks < 2; ++ks) {
                LAS unsigned char* va = Vs + (32 * ks + 4 * g + tq) * RV_STRIDE + (w * 16 + 4 * tp) * 2;
                vfrag[ks] = cat8(tr_read(va), tr_read(va + 16 * RV_STRIDE));
            }
            {
                LAS unsigned char* ka0 = Ks + (4 * g + tq) * RK_STRIDE + (4 * tp) * 2;
#define RET_KF(idx) cat8(tr_read(ka0 + ((idx) & 1) * 32 * RK_STRIDE + ((idx) >> 1) * 32), tr_read(ka0 + ((idx) & 1) * 32 * RK_STRIDE + ((idx) >> 1) * 32 + 16 * RK_STRIDE))
                bf16x8 kn0 = RET_KF(0), kn1 = RET_KF(1), kn2 = RET_KF(2);
#pragma unroll
                for (int dkb = 0; dkb < 16; ++dkb) {
#pragma unroll
                    for (int ks = 0; ks < 2; ++ks) {
                        const int idx = dkb * 2 + ks; const bf16x8 a = kn0; kn0 = kn1; kn1 = kn2;
                        if (idx + 3 < 32) kn2 = RET_KF(idx + 3);
                        S[dkb] = __builtin_amdgcn_mfma_f32_16x16x32_bf16(a, vfrag[ks], S[dkb], 0, 0, 0);
                        __builtin_amdgcn_sched_barrier(0);
                    }
                    S[dkb] = S[dkb] * cdec;
                }
#undef RET_KF
            }
            __syncthreads();
#pragma unroll
            for (int ib = 0; ib < 4; ++ib)
#pragma unroll
                for (int ks = 0; ks < 2; ++ks) {
                    const LAS unsigned char* pa = Ps + (ib * 16 + li) * RP_STRIDE + (32 * ks + 4 * g) * 2;
                    const bf16x8 a = cat8(*(const LAS s16x4*)pa, *(const LAS s16x4*)(pa + 32));
                    oacc[ib] = __builtin_amdgcn_mfma_f32_16x16x32_bf16(a, vfrag[ks], oacc[ib], 0, 0, 0);
                }
            {
                bf16_t* ob = OFB + ((size_t)dir * MT + rowbase) * EB + h * 512 + slice * 128 + w * 16 + li;
#pragma unroll
                for (int ib = 0; ib < 4; ++ib)
#pragma unroll
                    for (int r = 0; r < 4; ++r) { const unsigned pk2 = cvt_pk_bf16(oacc[ib][r], 0.f); ob[(size_t)(ib * 16 + 4 * g + r) * EB] = (bf16_t)(pk2 & 0xffffu); }
            }
        }
#undef RET_LOAD
#undef RET_ROWBASE
    }
}
__device__ __forceinline__ void ret_phaseB(const Params& p) {
    unsigned char* ws_ = opq(p.ws);
    const int tid = opaque_tid(), lane = tid & 63, wave = tid >> 6;
    const int gw = blockIdx.x * 8 + wave, NGW = gridDim.x * 8;
    const bf16_t* PROJ = (const bf16_t*)(ws_ + WS_PROJ);
    const bf16_t* OFB = (const bf16_t*)(ws_ + WS_OFB);
    bf16_t* GATED = (bf16_t*)(ws_ + WS_GATED);
    for (int it0 = gw * 6; it0 < MT * 8; it0 += NGW * 6) {
        u32x4 of[6], ob[6], gg[6];
#pragma unroll
        for (int q = 0; q < 6; ++q) { const int item = it0 + q; const int m = item >> 3, h = item & 7; const size_t off = (size_t)m * EB + h * 512 + lane * 8;
            of[q] = *(const u32x4*)(OFB + off); ob[q] = *(const u32x4*)(OFB + (size_t)MT * EB + off); gg[q] = *(const u32x4*)(PROJ + (size_t)m * NP_RET + 8192 + h * 512 + lane * 8); }
#pragma unroll
        for (int q = 0; q < 6; ++q) { const int item = it0 + q; const int m = item >> 3, h = item & 7; const size_t off = (size_t)m * EB + h * 512 + lane * 8;
            float o[8]; float ss = 0.f;
#pragma unroll
            for (int e = 0; e < 4; ++e) { o[2 * e] = bf_lo(of[q][e]) + bf_lo(ob[q][e]); o[2 * e + 1] = bf_hi(of[q][e]) + bf_hi(ob[q][e]); ss += o[2 * e] * o[2 * e] + o[2 * e + 1] * o[2 * e + 1]; }
            ss = wave_sum(ss);
            const float rn = 1.0f / sqrtf(ss * (1.0f / 512.0f) + EPS);
            u32x4 r;
#pragma unroll
            for (int e = 0; e < 4; ++e) { const float g0 = bf_lo(gg[q][e]), g1 = bf_hi(gg[q][e]); r[e] = cvt_pk_bf16(silu_f(g0) * o[2 * e] * rn, silu_f(g1) * o[2 * e + 1] * rn); }
            *(u32x4*)(GATED + off) = r; }
    }
}

constexpr int NA_KSTR = 272, NA_VSTR = 288, NA_VOFF = 17408, NA_BUF = 35840, NA_RPB = 71680, NA_QOFF = 73728, NA_QW = 8704;
constexpr float LOG2E = 1.4426950408889634f;
struct NaQ { f32x4 o[8]; float m, l, pend; };
__device__ __forceinline__ bf16x8 na_softmax(const f32x4 s0, const f32x4 s1, NaQ& q, const bool first) {
    const float x = fmaxf(fmaxf(fmaxf(s0[0], s0[1]), fmaxf(s0[2], s0[3])), fmaxf(fmaxf(s1[0], s1[1]), fmaxf(s1[2], s1[3])));
    const float xa = __shfl_xor(x, 16), xb = __shfl_xor(x, 32), xc = __shfl_xor(x, 48);
    if (first) { const float tmax = fmaxf(fmaxf(x, xa), fmaxf(xb, xc)); q.m = tmax; q.pend = tmax; }
    else {
        const bool need = q.pend > q.m + 8.0f;
        if (__builtin_amdgcn_ballot_w64(need) != 0ull) {
            const float mnew = need ? q.pend : q.m; const float alpha = __builtin_amdgcn_exp2f(q.m - mnew);
#pragma unroll
            for (int db = 0; db < 8; ++db) q.o[db] = q.o[db] * alpha;
            q.l *= alpha; q.m = mnew;
        }
    }
    f32x4 p0, p1;
#pragma unroll
    for (int rr = 0; rr < 4; ++rr) { p0[rr] = __builtin_amdgcn_exp2f(s0[rr] - q.m); p1[rr] = __builtin_amdgcn_exp2f(s1[rr] - q.m); }
    q.l += ((p0[0] + p0[1]) + (p0[2] + p0[3])) + ((p1[0] + p1[1]) + (p1[2] + p1[3]));
    const bf16x8 pf = pack8(p0, p1);
    if (!first) q.pend = fmaxf(q.pend, fmaxf(fmaxf(x, xa), fmaxf(xb, xc)));
    return pf;
}
__device__ __forceinline__ void na_group2(const bool f0, const bool f1, const LAS unsigned char* Qw, LAS unsigned char* Kb, LAS unsigned char* Vb, int cb, bool local, int rb0, const LAS float* rpbs, float sc2,
                                          unsigned vmask, int cbase, NaQ& q0, NaQ& q1, int li, int g, int tq, int tp) {
    f32x4 s00 = (f32x4){0.f, 0.f, 0.f, 0.f}, s01 = s00, s10 = s00, s11 = s00;
#pragma unroll
    for (int kk = 0; kk < 4; ++kk) {
        const bf16x8 ka = *(const LAS bf16x8*)(Kb + (cb + li) * NA_KSTR + (kk * 32 + 8 * g) * 2);
        const bf16x8 kb = *(const LAS bf16x8*)(Kb + (cb + 16 + li) * NA_KSTR + (kk * 32 + 8 * g) * 2);
        const bf16x8 qa = *(const LAS bf16x8*)(Qw + li * NA_KSTR + (kk * 32 + 8 * g) * 2);
        const bf16x8 qb2 = *(const LAS bf16x8*)(Qw + (16 + li) * NA_KSTR + (kk * 32 + 8 * g) * 2);
        s00 = __builtin_amdgcn_mfma_f32_16x16x32_bf16(ka, qa, s00, 0, 0, 0); s01 = __builtin_amdgcn_mfma_f32_16x16x32_bf16(kb, qa, s01, 0, 0, 0);
        s10 = __builtin_amdgcn_mfma_f32_16x16x32_bf16(ka, qb2, s10, 0, 0, 0); s11 = __builtin_amdgcn_mfma_f32_16x16x32_bf16(kb, qb2, s11, 0, 0, 0);
    }
    s00 = s00 * sc2; s01 = s01 * sc2; s10 = s10 * sc2; s11 = s11 * sc2;
    if (local) { const int rb1 = rb0 - 31;
#pragma unroll
        for (int k = 0; k < 4; ++k) { const bool v0 = (vmask >> k) & 1u, v1 = (vmask >> (k + 4)) & 1u;
            const int c0 = min(max(cbase + k, 0), 30), c1 = min(max(cbase + 16 + k, 0), 30);
            float b00 = rpbs[rb0 + c0], b01 = rpbs[rb0 + c1], b10 = rpbs[rb1 + c0], b11 = rpbs[rb1 + c1];
            asm volatile("" : "+v"(b00), "+v"(b01), "+v"(b10), "+v"(b11));
            s00[k] = v0 ? s00[k] + b00 : -INFINITY; s01[k] = v1 ? s01[k] + b01 : -INFINITY;
            s10[k] = v0 ? s10[k] + b10 : -INFINITY; s11[k] = v1 ? s11[k] + b11 : -INFINITY; } }
    const bf16x8 pf0 = na_softmax(s00, s01, q0, f0);
    const bf16x8 pf1 = na_softmax(s10, s11, q1, f1);
    LAS unsigned char* va0 = Vb + (cb + 4 * g + tq) * NA_VSTR + (4 * tp) * 2;
    bf16x8 an0 = cat8(tr_read(va0), tr_read(va0 + 16 * NA_VSTR));
    bf16x8 an1 = cat8(tr_read(va0 + 32), tr_read(va0 + 32 + 16 * NA_VSTR));
    bf16x8 an2 = cat8(tr_read(va0 + 64), tr_read(va0 + 64 + 16 * NA_VSTR));
#pragma unroll
    for (int db = 0; db < 8; ++db) {
        const bf16x8 a = an0; an0 = an1; an1 = an2;
        if (db + 3 < 8) { LAS unsigned char* va = va0 + (db + 3) * 32; an2 = cat8(tr_read(va), tr_read(va + 16 * NA_VSTR)); }
        q0.o[db] = __builtin_amdgcn_mfma_f32_16x16x32_bf16(a, pf0, q0.o[db], 0, 0, 0);
        q1.o[db] = __builtin_amdgcn_mfma_f32_16x16x32_bf16(a, pf1, q1.o[db], 0, 0, 0);
        __builtin_amdgcn_sched_barrier(0);
    }
}
__device__ __forceinline__ void na_group1(const bool f, const LAS unsigned char* Qw, LAS unsigned char* Kb, LAS unsigned char* Vb, int cb, int rb, const LAS float* rpbs, float sc2,
                                          unsigned vmask, int cbase, NaQ& q, int li, int g, int tq, int tp) {
    f32x4 s0 = (f32x4){0.f, 0.f, 0.f, 0.f}, s1 = s0;
#pragma unroll
    for (int kk = 0; kk < 4; ++kk) {
        const bf16x8 ka = *(const LAS bf16x8*)(Kb + (cb + li) * NA_KSTR + (kk * 32 + 8 * g) * 2);
        const bf16x8 kb = *(const LAS bf16x8*)(Kb + (cb + 16 + li) * NA_KSTR + (kk * 32 + 8 * g) * 2);
        const bf16x8 qa = *(const LAS bf16x8*)(Qw + li * NA_KSTR + (kk * 32 + 8 * g) * 2);
        s0 = __builtin_amdgcn_mfma_f32_16x16x32_bf16(ka, qa, s0, 0, 0, 0); s1 = __builtin_amdgcn_mfma_f32_16x16x32_bf16(kb, qa, s1, 0, 0, 0);
    }
    s0 = s0 * sc2; s1 = s1 * sc2;
#pragma unroll
    for (int k = 0; k < 4; ++k) { const bool v0 = (vmask >> k) & 1u, v1 = (vmask >> (k + 4)) & 1u;
        const int c0 = min(max(cbase + k, 0), 30), c1 = min(max(cbase + 16 + k, 0), 30);
        float b0 = rpbs[rb + c0], b1 = rpbs[rb + c1]; asm volatile("" : "+v"(b0), "+v"(b1));
        s0[k] = v0 ? s0[k] + b0 : -INFINITY; s1[k] = v1 ? s1[k] + b1 : -INFINITY; }
    const bf16x8 pf = na_softmax(s0, s1, q, f);
    LAS unsigned char* va0 = Vb + (cb + 4 * g + tq) * NA_VSTR + (4 * tp) * 2;
    bf16x8 an0 = cat8(tr_read(va0), tr_read(va0 + 16 * NA_VSTR));
    bf16x8 an1 = cat8(tr_read(va0 + 32), tr_read(va0 + 32 + 16 * NA_VSTR));
#pragma unroll
    for (int db = 0; db < 8; ++db) {
        const bf16x8 a = an0; an0 = an1;
        if (db + 2 < 8) { LAS unsigned char* va = va0 + (db + 2) * 32; an1 = cat8(tr_read(va), tr_read(va + 16 * NA_VSTR)); }
        q.o[db] = __builtin_amdgcn_mfma_f32_16x16x32_bf16(a, pf, q.o[db], 0, 0, 0);
        __builtin_amdgcn_sched_barrier(0);
    }
}
__device__ __forceinline__ void na_phase(const Params& p, int j, bool with_ctx, LAS unsigned char* lds) {
    unsigned char* ws_ = opq(p.ws);
    const int tid = opaque_tid(), lane = tid & 63, w = __builtin_amdgcn_readfirstlane(tid >> 6), g = lane >> 4, li = lane & 15;
    const int tq = li >> 2, tp = li & 3;
    const bf16_t* PROJ = (const bf16_t*)(ws_ + WS_PROJ);
    bf16_t* GATED = (bf16_t*)(ws_ + WS_GATED);
    LAS float* rpbs = (LAS float*)(lds + NA_RPB);
    const float sc2 = 0.08838834764831845f * LOG2E;
    const int NU = 1024 + (with_ctx ? 128 : 0);
    for (int u = blockIdx.x; u < NU; u += gridDim.x) {
        const bool isctx = u >= 1024;
        int b, head, qb = 0, r0 = 0, rs0 = 0, nloc = 0, qrow0, qrow1, rsw0 = 0, rsw1 = 0;
        if (!isctx) {
            const int rnd = u / (int)gridDim.x, bx = u - rnd * (int)gridDim.x; const int grp = (gridDim.x == 256) ? rnd * 32 + (bx & 7) * 4 + (bx >> 6) : (u >> 3);
            const int rq = (gridDim.x == 256) ? ((bx >> 3) & 7) : (u & 7); b = grp >> 5; head = grp & 31; qb = w & 3; r0 = 4 * rq + 2 * (w >> 2);
            qrow0 = b * SEQ + r0 * 64 + qb * 16; qrow1 = qrow0 + 64; rsw0 = min(max(r0 - 4, 0), 24); rsw1 = min(max(r0 - 3, 0), 24);
            rs0 = min(max(4 * rq - 4, 0), 24); nloc = min(max(4 * rq - 1, 0), 24) + 8 - rs0; }
        else { const int v = u - 1024; b = v >> 5; head = v & 31; qrow0 = ML + b * CTXL + w * 16; qrow1 = qrow0 + 128; }
        const int nit = nloc + 4;
        const int cb_loc = (qb == 0) ? 0 : (qb == 1) ? 8 : (qb == 2) ? 24 : 32;
        if (tid < 465) rpbs[tid] = opq(p.na_rpb)[(size_t)(j * 32 + head) * 465 + tid] * LOG2E;
        unsigned vmask = 0; const int cbase = cb_loc + 4 * g - (qb * 16 + li) + 15;
        { const int qc = qb * 16 + li; const int wsx = min(max(qc - 8, 0), 48);
#pragma unroll
          for (int k = 0; k < 8; ++k) { const int kc = cb_loc + (k >> 2) * 16 + 4 * g + (k & 3); vmask |= ((kc >= wsx) && (kc < wsx + 16)) ? (1u << k) : 0u; } }
        NaQ q0, q1;
        LAS unsigned char* Qw = lds + NA_QOFF + w * NA_QW;
#pragma unroll
        for (int db = 0; db < 8; ++db) { q0.o[db] = (f32x4){0.f, 0.f, 0.f, 0.f}; q1.o[db] = (f32x4){0.f, 0.f, 0.f, 0.f}; }
        q0.m = 0.f; q1.m = 0.f; q0.l = 0.f; q1.l = 0.f; q0.pend = 0.f; q1.pend = 0.f;
        u32x4 pA[2][2];
#define NA_LOAD(it, R) do { const int trow_ = ((it) < nloc) ? b * SEQ + (rs0 + (it)) * 64 : ML + b * CTXL + ((it) - nloc) * 64; _Pragma("unroll") for (int t = 0; t < 2; ++t) { const int idx = tid + 512 * t; \
        const bf16_t* sp = PROJ + (size_t)(trow_ + (idx >> 4)) * NP_NA + 4096 + head * 128 + (idx & 15) * 8; R[t][0] = *(const u32x4*)sp; R[t][1] = *(const u32x4*)(sp + 4096); } } while (0)
#define NA_STORE(buf, R) do { _Pragma("unroll") for (int t = 0; t < 2; ++t) { const int idx = tid + 512 * t; LAS unsigned char* dp = lds + (buf) * NA_BUF; \
        *(LAS u32x4*)(dp + (idx >> 4) * NA_KSTR + (idx & 15) * 16) = R[t][0]; *(LAS u32x4*)(dp + NA_VOFF + (idx >> 4) * NA_VSTR + (idx & 15) * 16) = R[t][1]; } } while (0)
        {
            u32x4 qv[8];
#pragma unroll
            for (int i = 0; i < 8; ++i) { const int c = lane + 64 * i, row = c >> 4, ch = c & 15;
                qv[i] = *(const u32x4*)(PROJ + (size_t)((row < 16 ? qrow0 : qrow1) + (row & 15)) * NP_NA + head * 128 + ch * 8); }
            NA_LOAD(0, pA);
#pragma unroll
            for (int i = 0; i < 8; ++i) { const int c = lane + 64 * i, row = c >> 4, ch = c & 15; *(LAS u32x4*)(Qw + row * NA_KSTR + ch * 16) = qv[i]; }
            NA_STORE(0, pA);
        }
        __syncthreads();
        for (int it = 0; it < nit; ++it) {
            const int cur = it & 1;
            if (it + 1 < nit) NA_LOAD(it + 1, pA);
            const bool local = it < nloc; const int kr = rs0 + it;
            LAS unsigned char* Kb = lds + cur * NA_BUF; LAS unsigned char* Vb = Kb + NA_VOFF;
            if (local) {
                const bool act0 = (kr >= rsw0 && kr < rsw0 + 8), act1 = (kr >= rsw1 && kr < rsw1 + 8); const int rb0 = (kr - r0 + 7) * 31;
                if (act0 && act1) na_group2(kr == rsw0, kr == rsw1, Qw, Kb, Vb, cb_loc, true, rb0, rpbs, sc2, vmask, cbase, q0, q1, li, g, tq, tp);
                else if (act0) na_group1(kr == rsw0, Qw, Kb, Vb, cb_loc, rb0, rpbs, sc2, vmask, cbase, q0, li, g, tq, tp);
                else if (act1) na_group1(kr == rsw1, Qw + 16 * NA_KSTR, Kb, Vb, cb_loc, rb0 - 31, rpbs, sc2, vmask, cbase, q1, li, g, tq, tp);
            } else {
                const bool f_ = isctx && it == 0;
                for (int gi = 0; gi < 2; ++gi) na_group2(f_ && gi == 0, f_ && gi == 0, Qw, Kb, Vb, gi * 32, false, 0, rpbs, sc2, vmask, cbase, q0, q1, li, g, tq, tp);
            }
            if (it + 1 < nit) NA_STORE(cur ^ 1, pA);
            __syncthreads();
        }
#undef NA_LOAD
#undef NA_STORE
        {
            u32x2 ggv[2][8];
#pragma unroll
            for (int t = 0; t < 2; ++t) { const size_t row = (size_t)((t ? qrow1 : qrow0) + li);
#pragma unroll
                for (int db = 0; db < 8; ++db) ggv[t][db] = *(const u32x2*)(PROJ + row * NP_NA + 12288 + head * 128 + db * 16 + 4 * g); }
#pragma unroll
            for (int t = 0; t < 2; ++t) {
                float lt = t ? q1.l : q0.l; lt += __shfl_xor(lt, 16); lt += __shfl_xor(lt, 32);
                const float inv = 1.0f / lt; const size_t row = (size_t)((t ? qrow1 : qrow0) + li);
#pragma unroll
                for (int db = 0; db < 8; ++db) { const int d = db * 16 + 4 * g; const f32x4 ov = t ? q1.o[db] : q0.o[db]; const u32x2 gg = ggv[t][db];
                    u32x2 wv; wv.x = cvt_pk_bf16(ov[0] * inv * silu_f(bf_lo(gg.x)), ov[1] * inv * silu_f(bf_hi(gg.x)));
                    wv.y = cvt_pk_bf16(ov[2] * inv * silu_f(bf_lo(gg.y)), ov[3] * inv * silu_f(bf_hi(gg.y)));
                    *(u32x2*)(GATED + row * EB + head * 128 + d) = wv; }
            }
        }
    }
}

#define XB_TMO      128
#define XB_XCNT(j)  (256  + 64 * (j))
#define XB_XSUB(j)  (1280 + 64 * (j))
#define XB_XGEN(j)  (2304 + 64 * (j))
#define XB_TOP      3328
#define XB_TOPGEN   3392
#define XCD_BAR_WORDS 3456
#define XB_SPIN_CAP (1u << 20)
__device__ __forceinline__ unsigned xb_ld(unsigned* p)              { return __hip_atomic_load(p, __ATOMIC_RELAXED, __HIP_MEMORY_SCOPE_AGENT); }
__device__ __forceinline__ unsigned xb_add(unsigned* p, unsigned v) { return __hip_atomic_fetch_add(p, v, __ATOMIC_RELAXED, __HIP_MEMORY_SCOPE_AGENT); }
__device__ __forceinline__ unsigned xb_xcc_id() { return (unsigned)__builtin_amdgcn_s_getreg((3 << 11) | 20) & 0xFu; }
#define XB_SPIN(cond, bar) do { unsigned _sp = 0; while (cond) { __builtin_amdgcn_s_sleep(1); \
    if ((++_sp & 255u) == 0u) { if (xb_ld(&(bar)[XB_TMO])) break; if (_sp > XB_SPIN_CAP) { atomicAdd(&(bar)[XB_TMO], 1u); break; } } } } while (0)
struct XcdBarrier { unsigned* bar; unsigned x; volatile LAS unsigned* st; };
__device__ __forceinline__ XcdBarrier xcd_barrier_post(unsigned* bar, volatile LAS unsigned* st) {
    XcdBarrier b; b.bar = bar; b.x = xb_xcc_id(); b.st = st;
    if (threadIdx.x == 0) (void)xb_add(&bar[XB_XCNT(b.x)], 1u);
    return b;
}
__device__ __forceinline__ void xcd_barrier_complete(unsigned* bar, unsigned x, unsigned& nloc, unsigned& nx) {
    const unsigned G = gridDim.x * gridDim.y * gridDim.z;
    unsigned sum, cnt, mine, sp = 0u;
    for (;;) {
        sum = 0u; cnt = 0u; mine = 0u;
#pragma unroll
        for (unsigned j = 0; j < 16; ++j) { const unsigned c = xb_ld(&bar[XB_XCNT(j)]); sum += c; cnt += (c > 0u) ? 1u : 0u; mine = (j == x) ? c : mine; }
        if (sum == G) break;
        __builtin_amdgcn_s_sleep(1);
        if ((++sp & 255u) == 0u) { if (xb_ld(&bar[XB_TMO])) break; if (sp > XB_SPIN_CAP) { atomicAdd(&bar[XB_TMO], 1u); break; } }
    }
    nloc = mine > 0u ? mine : 1u; nx = cnt > 0u ? cnt : 1u;
}
__device__ __forceinline__ void xcd_barrier(const XcdBarrier& b) {
    asm volatile("s_waitcnt vmcnt(0)" ::: "memory");
    __syncthreads();
    if (threadIdx.x == 0) {
        unsigned* bar = b.bar;
        __builtin_amdgcn_s_waitcnt(0);
        unsigned nloc = b.st[0], nx = b.st[1];
        if (nloc == 0u) { xcd_barrier_complete(bar, b.x, nloc, nx); b.st[0] = nloc; b.st[1] = nx; }
        const unsigned old = xb_add(&bar[XB_XSUB(b.x)], 1u);
        const unsigned gen = old / nloc;
        if (old + 1u == (gen + 1u) * nloc) {
            __builtin_amdgcn_fence(__ATOMIC_RELEASE, "agent");
            asm volatile("s_waitcnt vmcnt(0)" ::: "memory");
            const unsigned og = xb_add(&bar[XB_TOP], 1u);
            const unsigned tg = og / nx;
            if (og + 1u == (tg + 1u) * nx) xb_add(&bar[XB_TOPGEN], 1u);
            else XB_SPIN(xb_ld(&bar[XB_TOPGEN]) == tg, bar);
            __builtin_amdgcn_fence(__ATOMIC_ACQUIRE, "agent");
            xb_add(&bar[XB_XGEN(b.x)], 1u);
            asm volatile("s_waitcnt vmcnt(0)" ::: "memory");
        } else {
            XB_SPIN(xb_ld(&bar[XB_XGEN(b.x)]) == gen, bar);
            __builtin_amdgcn_fence(__ATOMIC_ACQUIRE, "agent");
            asm volatile("s_waitcnt vmcnt(0)" ::: "memory");
        }
    }
    __syncthreads();
}

__global__ void __launch_bounds__(512, 2) fwd_megakernel(Params p) {
    extern __shared__ __attribute__((aligned(16))) unsigned char smem[];
    LAS unsigned char* lds = (LAS unsigned char*)smem;
    cg::grid_group grid = cg::this_grid();
    unsigned* barw = (unsigned*)(opq(p.ws) + WS_BAR);
    volatile LAS unsigned* bst = (volatile LAS unsigned*)(lds + LDS_BYTES - 64);
    if (blockIdx.x == 0) for (int i = threadIdx.x; i < XCD_BAR_WORDS; i += 512) barw[i] = 0u;
    if (threadIdx.x < 2) bst[threadIdx.x] = 0u;
#ifndef NO_PRO
    prologue(p, lds);
#endif
    grid.sync();
    const XcdBarrier xbar = xcd_barrier_post(barw, bst);
#define GSYNC() xcd_barrier(xbar)
    const bf16_t* H = (const bf16_t*)(opq(p.ws) + WS_H);
    bf16_t* PROJ = (bf16_t*)(opq(p.ws) + WS_PROJ);
    const bf16_t* GATED = (const bf16_t*)(opq(p.ws) + WS_GATED);
    float* XS = (float*)(opq(p.ws) + WS_XS);
    for (int l = 0; l < 4; ++l) {
        const int j = l >> 1; const bool isna = (l & 1) != 0;
        norm_phase(p, l);
        GSYNC();
        {
            const int N = isna ? NP_NA : NP_RET;
            const bf16_t* Bt = (const bf16_t*)(opq(p.ws) + (isna ? (j ? WS_WNI1 : WS_WNI0) : (j ? WS_WRI1 : WS_WRI0)));
            pg8::Gemm gm{H, Bt, MT, N, DM, DM}; pg8::StaticOrder S; S.init(MT, N, (int)gridDim.x, (int)blockIdx.x);
            pg8::EpiBf16 E{PROJ, N};
#ifndef NO_G1
            pg8::gemm_phase<pg8::EpiBf16, pg8::StaticOrder>(lds, gm, S, E);
#endif
        }
        GSYNC();
#ifndef NO_RETA
        if (!isna) { ret_phaseA(p, j, lds); GSYNC(); ret_phaseB(p); }
#endif
#ifndef NO_NA
        if (isna) na_phase(p, j, l != 3, lds);
#endif
        GSYNC();
        {
            const bf16_t* Bt = (const bf16_t*)(opq(p.ws) + (isna ? (j ? WS_WNO1 : WS_WNO0) : (j ? WS_WRO1 : WS_WRO0)));
            {
                pg8::Gemm gm{GATED, Bt, ML, DM, EB, EB}; pg8::StaticOrder S; S.init(ML, DM, (int)gridDim.x, (int)blockIdx.x);
                pg8::EpiResid E{(l == 0) ? (const float*)opq(p.x) : (const float*)XS, XS, (const float*)(opq(p.ws) + WS_MODV) + (size_t)l * 5 * 6144 + 4096};
                pg8::gemm_phase<pg8::EpiResid, pg8::StaticOrder>(lds, gm, S, E);
            }
            if (l != 3) {
                pg8::Gemm gm{GATED + (size_t)ML * EB, Bt, MC, DM, EB / 8, EB}; pg8::SplitOrder S; S.init(MC, DM, 8, (int)gridDim.x, (int)blockIdx.x);
                pg8::EpiPartial E{(float*)(opq(p.ws) + WS_PART), MC, DM};
                pg8::gemm_phase<pg8::EpiPartial, pg8::SplitOrder>(lds, gm, S, E);
            }
        }
        GSYNC();
    }
    final_norm(p);
}

extern "C" void kernel_launch(void* const* d_in, const int* in_sizes, int n_in, void* d_out, int out_size, void* d_ws, size_t ws_size, hipStream_t stream) {
    static int grid_blocks = 0;
    if (grid_blocks == 0) {
        if (ws_size < WS_END) { fprintf(stderr, "kernel_launch: workspace too small (%zu < %zu)\n", ws_size, (size_t)WS_END); grid_blocks = -1; return; }
        int dev = 0, cus = 0, per_cu = 0;
        hipGetDevice(&dev);
        hipDeviceGetAttribute(&cus, hipDeviceAttributeMultiprocessorCount, dev);
        if (hipFuncSetAttribute((const void*)fwd_megakernel, hipFuncAttributeMaxDynamicSharedMemorySize, LDS_BYTES) != hipSuccess) { fprintf(stderr, "kernel_launch: hipFuncSetAttribute failed\n"); }
        if (hipOccupancyMaxActiveBlocksPerMultiprocessor(&per_cu, (const void*)fwd_megakernel, 512, LDS_BYTES) != hipSuccess || per_cu < 1) { fprintf(stderr, "kernel_launch: occupancy query says %d\n", per_cu); per_cu = 1; }
        (void)hipGetLastError();
        grid_blocks = cus * 1;
        if (grid_blocks <= 0) grid_blocks = 256;
    }
    if (grid_blocks < 0) return;
    Params p{};
    p.x = (const float*)d_in[0]; p.c = (const float*)d_in[1]; p.ctx = (const float*)d_in[2]; p.c_ctx = (const float*)d_in[3];
    p.mod_w = (const float*)d_in[4]; p.mod_b = (const float*)d_in[5]; p.norm_g = (const float*)d_in[6]; p.ret_w_in = (const float*)d_in[7];
    p.ret_df = (const float*)d_in[8]; p.ret_db = (const float*)d_in[9]; p.ret_w_out = (const float*)d_in[10]; p.na_w_in = (const float*)d_in[11];
    p.na_rpb = (const float*)d_in[12]; p.na_w_out = (const float*)d_in[13]; p.final_g = (const float*)d_in[14];
    p.out = (float*)d_out; p.ws = (unsigned char*)d_ws;
    void* args[] = {&p};
    hipError_t e = hipLaunchCooperativeKernel((const void*)fwd_megakernel, dim3(grid_blocks), dim3(512), args, LDS_BYTES, stream);
    if (e != hipSuccess) fprintf(stderr, "cooperative launch failed: %s (grid %d)\n", hipGetErrorString(e), grid_blocks);
}
```
